# Optimizing an MI355X kernel written in HIP

```python
import math
import jax, jax.numpy as jnp
from jax import lax
import numpy as np

D_MODEL = 2048
BATCH = 1
SEQ = 8192
DEPTH = 2
DEC_BATCH = 16
DEC_SEQ = 64
PAST_LEN = 4096

CHUNK = 64
N_LEFT_CHUNKS = 8
LEFT_ROWS = N_LEFT_CHUNKS * CHUNK
BAND = (N_LEFT_CHUNKS + 1) * CHUNK
N_HEADS = 16
HEAD_DIM = D_MODEL // N_HEADS
MAX_REL = 256
N_REL = 2 * MAX_REL + 1
CONV_W = 3
D_FF = -(-8 * D_MODEL // (3 * 256)) * 256
N_A = DEPTH // 2
N_B = DEPTH - N_A
ALPHA = (2.0 * DEPTH) ** 0.25
BETA = (8.0 * DEPTH) ** -0.25
LN_EPS = 1e-5

kernel_name = "yoco_shortconv_chunkband_deepnorm_step"


def layer_norm(x, g, b):
    xf = x.astype(jnp.float32)
    mu = jnp.mean(xf, axis=-1, keepdims=True)
    var = jnp.mean(jnp.square(xf - mu), axis=-1, keepdims=True)
    return ((xf - mu) * lax.rsqrt(var + LN_EPS) * g + b).astype(x.dtype)


def post_norm(x, sub, g, b):
    return layer_norm(ALPHA * x + sub, g, b)


def swiglu(x, w_gate_up, w_down):
    g, u = jnp.split(x @ w_gate_up, 2, axis=-1)
    return (jax.nn.silu(g) * u) @ w_down


def short_conv_mixer(x, hist, w_in, conv_w, w_out):
    s = x.shape[1]
    b, c, h = jnp.split(x @ w_in, 3, axis=-1)
    u = c * h
    full = jnp.concatenate([hist.astype(u.dtype), u], axis=1)
    conv = conv_w[0] * full[:, 0:s]
    for t in range(1, CONV_W):
        conv = conv + conv_w[t] * full[:, t:t + s]
    return (b * conv) @ w_out, full[:, -(CONV_W - 1):]


def rel_bias_lookup(rel_bias, rel):
    return rel_bias[:, jnp.clip(rel, -MAX_REL, MAX_REL) + MAX_REL]


def band_attention_prompt(q, k, v, rel_bias):
    n, s = q.shape[:2]
    nc = s // CHUNK
    pad = jnp.zeros((n, LEFT_ROWS, N_HEADS, HEAD_DIM), k.dtype)
    kp = jnp.concatenate([pad, k], axis=1)
    vp = jnp.concatenate([pad.astype(v.dtype), v], axis=1)
    idx = jnp.arange(nc)[:, None] * CHUNK + jnp.arange(BAND)[None, :]
    kb = kp[:, idx]
    vb = vp[:, idx]
    qc = q.reshape(n, nc, CHUNK, N_HEADS, HEAD_DIM)
    rel = jnp.arange(CHUNK)[:, None] - jnp.arange(BAND)[None, :] + LEFT_ROWS
    bias = rel_bias_lookup(rel_bias, rel).astype(jnp.float32)
    valid = (idx - LEFT_ROWS) >= 0
    scores = jnp.einsum('ncqhd,nckhd->nchqk', qc, kb).astype(jnp.float32) * (HEAD_DIM ** -0.5)
    scores = jnp.where(valid[None, :, None, None, :], scores + bias[None, None], -jnp.inf)
    p = jax.nn.softmax(scores, axis=-1).astype(v.dtype)
    out = jnp.einsum('nchqk,nckhd->ncqhd', p, vb)
    return out.reshape(n, s, N_HEADS * HEAD_DIM)


def attention_with_past(q, k_all, v_all, rel_bias, n_past):
    n, s = q.shape[:2]
    rel = (n_past + jnp.arange(s))[:, None] - jnp.arange(n_past + s)[None, :]
    bias = rel_bias_lookup(rel_bias, rel).astype(jnp.float32)
    scores = jnp.einsum('nqhd,nkhd->nhqk', q, k_all).astype(jnp.float32) * (HEAD_DIM ** -0.5)
    p = jax.nn.softmax(scores + bias[None], axis=-1).astype(v_all.dtype)
    out = jnp.einsum('nhqk,nkhd->nqhd', p, v_all)
    return out.reshape(n, s, N_HEADS * HEAD_DIM)


def run_trunk(x, conv_hist, cache_k, cache_v, w_in_a, conv_w, w_out_a, w_kv, w_q, w_o,
              rel_bias, ln_g, ln_b, w_gate_up, w_down):
    n, s, _ = x.shape
    new_conv = []
    k = v = k_all = v_all = None
    for l in range(DEPTH):
        if l < N_A:
            mix, st = short_conv_mixer(x, conv_hist[l], w_in_a[l], conv_w[l], w_out_a[l])
            new_conv.append(st)
        else:
            if l == N_A:
                k, v = jnp.split(x @ w_kv, 2, axis=-1)
                k = k.reshape(n, s, N_HEADS, HEAD_DIM)
                v = v.reshape(n, s, N_HEADS, HEAD_DIM)
                if cache_k is not None:
                    k_all = jnp.concatenate([cache_k.astype(k.dtype), k], axis=1)
                    v_all = jnp.concatenate([cache_v.astype(v.dtype), v], axis=1)
            bl = l - N_A
            q = (x @ w_q[bl]).reshape(n, s, N_HEADS, HEAD_DIM)
            if cache_k is None:
                att = band_attention_prompt(q, k, v, rel_bias[bl])
            else:
                att = attention_with_past(q, k_all, v_all, rel_bias[bl], cache_k.shape[1])
            mix = att @ w_o[bl]
        x = post_norm(x, mix, ln_g[l, 0], ln_b[l, 0])
        x = post_norm(x, swiglu(x, w_gate_up[l], w_down[l]), ln_g[l, 1], ln_b[l, 1])
    return x, jnp.stack(new_conv), k, v


def setup_inputs(seed: int = 0) -> dict:
    key = jax.random.key(seed)
    ks = jax.random.split(key, 20)

    def nrm(k, shape, scale):
        return jax.random.normal(k, shape, jnp.float32) * scale

    r = min(LEFT_ROWS, PAST_LEN)
    d = D_MODEL
    x_prompt = nrm(ks[0], (BATCH, SEQ, d), 1.0)
    x_sample = nrm(ks[1], (DEC_BATCH, DEC_SEQ, d), 1.0)
    state_conv = nrm(ks[2], (N_A, DEC_BATCH, CONV_W - 1, d), 1.0)
    cache_k = nrm(ks[3], (DEC_BATCH, r, N_HEADS, HEAD_DIM), 1.0)
    cache_v = nrm(ks[4], (DEC_BATCH, r, N_HEADS, HEAD_DIM), 1.0)
    w_in_a = nrm(ks[5], (N_A, d, 3 * d), d ** -0.5)
    conv_w = nrm(ks[6], (N_A, CONV_W, d), CONV_W ** -0.5)
    w_out_a = nrm(ks[7], (N_A, d, d), BETA * d ** -0.5)
    w_kv = jnp.concatenate([nrm(ks[8], (d, d), d ** -0.5),
                            nrm(ks[9], (d, d), BETA * d ** -0.5)], axis=1)
    w_q = nrm(ks[10], (N_B, d, d), d ** -0.5)
    w_o = nrm(ks[11], (N_B, d, d), BETA * d ** -0.5)
    rel_bias = nrm(ks[12], (N_B, N_HEADS, N_REL), 0.1)
    ln_g = 1.0 + nrm(ks[13], (DEPTH, 2, d), 0.05)
    ln_b = nrm(ks[14], (DEPTH, 2, d), 0.05)
    w_gate_up = nrm(ks[15], (DEPTH, d, 2 * D_FF), d ** -0.5)
    w_down = nrm(ks[16], (DEPTH, D_FF, d), BETA * D_FF ** -0.5)
    return {"x_prompt": x_prompt, "x_sample": x_sample, "state_conv": state_conv,
            "cache_k": cache_k, "cache_v": cache_v, "w_in_a": w_in_a, "conv_w": conv_w,
            "w_out_a": w_out_a, "w_kv": w_kv, "w_q": w_q, "w_o": w_o, "rel_bias": rel_bias,
            "ln_g": ln_g, "ln_b": ln_b, "w_gate_up": w_gate_up, "w_down": w_down}


def reference(x_prompt, x_sample, state_conv, cache_k, cache_v, w_in_a, conv_w, w_out_a,
              w_kv, w_q, w_o, rel_bias, ln_g, ln_b, w_gate_up, w_down):
    weights = (w_in_a, conv_w, w_out_a, w_kv, w_q, w_o, rel_bias, ln_g, ln_b, w_gate_up, w_down)
    conv_zero = jnp.zeros((N_A, x_prompt.shape[0], CONV_W - 1, D_MODEL), x_prompt.dtype)
    y_prompt, conv_prompt, k_full, v_full = run_trunk(x_prompt, conv_zero, None, None, *weights)
    y_sample, conv_sample, k_sample, v_sample = run_trunk(x_sample, state_conv, cache_k, cache_v, *weights)
    k_prompt = k_full[:, -LEFT_ROWS:]
    v_prompt = v_full[:, -LEFT_ROWS:]
    return (y_prompt, y_sample, conv_prompt, conv_sample, k_prompt, v_prompt, k_sample, v_sample)
```

```cpp
#include <hip/hip_runtime.h>
#include <hip/hip_cooperative_groups.h>
#include <cstdio>
#include <cstdint>
#include <cmath>
namespace pg8 {
#define PG8_LAS __attribute__((address_space(3)))
typedef unsigned short bf16_t;
typedef short bf16x8 __attribute__((ext_vector_type(8)));
typedef float f32x4 __attribute__((ext_vector_type(4)));
typedef unsigned u32x4 __attribute__((ext_vector_type(4)));
constexpr int BM = 256, BK = 64, HALF = 128, HTB = HALF * BK * 2  , STAGE_BYTES = 8 * HTB, NXCD = 8, WGM = 8;

__host__ __device__ __forceinline__ int lds_byte(int r, int c) { const int st = (r >> 4) * 2 + (c >> 5), rr = r & 15, cc = c & 31, ob = rr * 64 + cc * 2; return st * 1024 + (ob ^ (((ob >> 9) & 1) << 5)); }
__host__ __device__ __forceinline__ void stage_rc(int b, int& R, int& C) { const int st = b / 1024, sb = b % 1024, swz = sb ^ (((sb >> 9) & 1) << 5); R = (st >> 1) * 16 + swz / 64; C = (st & 1) * 32 + (swz % 64) / 2; }
__host__ __device__ __forceinline__ int perm32(int rho) { const int n = rho >> 4, i = rho & 15; return 8 * (i >> 2) + 4 * n + (i & 3); }

struct Unit { int pm, pn; };
struct Gemm { const bf16_t* A; const bf16_t* Bt; int M, N, K; };

struct StaticOrder {
    int nM, nN, nwg, G, c;
    __host__ __device__ void init(int M, int N, int G_, int c_) { nM = M / BM; nN = N / BM; nwg = nM * nN; G = G_; c = c_; }
    __host__ __device__ bool next(int i, Unit& u) const {
        const long L = (long)i * G + c; if (L >= nwg) return false;
        int wgid = (int)L; { const int q = nwg / NXCD, r = nwg % NXCD, xcd = wgid % NXCD, off = wgid / NXCD; wgid = (xcd < r ? xcd * (q + 1) : r * (q + 1) + (xcd - r) * q) + off; }
        const int nig = WGM * nN, gid = wgid / nig, fm = gid * WGM, gsz = (nM - fm) < WGM ? (nM - fm) : WGM;
        u.pm = fm + ((wgid % nig) % gsz); u.pn = (wgid % nig) / gsz; return true;
    }
    __device__ __forceinline__ void a_ready(const Unit&) const {}
    __device__ __forceinline__ void done(const Unit&) const {}
};

__device__ __forceinline__ unsigned cvt_pk_bf16(float lo, float hi) { unsigned r; asm volatile("v_cvt_pk_bf16_f32 %0, %1, %2" : "=v"(r) : "v"(lo), "v"(hi)); return r; }
typedef float f32x2 __attribute__((ext_vector_type(2)));
typedef unsigned u32x2 __attribute__((ext_vector_type(2)));
constexpr int DM = 2048, DFF = 5632, NPROMPT = 8192;
__device__ __forceinline__ u32x4 pack8(const f32x4 a, const f32x4 b) { u32x4 w; w.x = cvt_pk_bf16(a[0], a[1]); w.y = cvt_pk_bf16(a[2], a[3]); w.z = cvt_pk_bf16(b[0], b[1]); w.w = cvt_pk_bf16(b[2], b[3]); return w; }

struct EpiInA {
    static constexpr bool PERM = true, AFTER_DRAIN = false;
    bf16_t* Bb; bf16_t* Ub; float* conv_p; float* conv_s;
    __device__ __forceinline__ void operator()(const f32x4 (&acc)[2][2][4][2], const Unit& u, int wr, int wc, int fr, int fq) const {
        const int row0 = u.pm * BM + wr * 64 + fr;
        if (u.pn < 8) {
            const int col0 = u.pn * BM + wc * 32 + 8 * fq;
#pragma unroll
            for (int ai = 0; ai < 2; ++ai)
#pragma unroll
                for (int m = 0; m < 4; ++m) { bf16_t* rowp = Bb + (size_t)(row0 + ai * HALF + m * 16) * DM + col0;
#pragma unroll
                    for (int bj = 0; bj < 2; ++bj) *(u32x4*)(rowp + bj * HALF) = pack8(acc[ai][bj][m][0], acc[ai][bj][m][1]); }
        } else {
            const int col0 = (u.pn - 8) * HALF + wc * 32 + 8 * fq;
#pragma unroll
            for (int ai = 0; ai < 2; ++ai)
#pragma unroll
                for (int m = 0; m < 4; ++m) { const int row = row0 + ai * HALF + m * 16;
                    const f32x4 v0 = acc[ai][0][m][0] * acc[ai][1][m][0], v1 = acc[ai][0][m][1] * acc[ai][1][m][1];
                    *(u32x4*)(Ub + (size_t)row * DM + col0) = pack8(v0, v1);
                    if (row >= NPROMPT - 64 && (row & 63) >= 62) {
                        float* dst = (row < NPROMPT) ? conv_p + (size_t)(row - (NPROMPT - 2)) * DM : conv_s + (size_t)((((row - NPROMPT) >> 6) << 1) + (row & 63) - 62) * DM;
                        *(f32x4*)(dst + col0) = v0; *(f32x4*)(dst + col0 + 4) = v1; } }
        }
    }
};
struct EpiSwiGLU {
    static constexpr bool PERM = true, AFTER_DRAIN = false;
    bf16_t* H;
    __device__ __forceinline__ void operator()(const f32x4 (&acc)[2][2][4][2], const Unit& u, int wr, int wc, int fr, int fq) const {
        const int row0 = u.pm * BM + wr * 64 + fr, col0 = u.pn * HALF + wc * 32 + 8 * fq;
#pragma unroll
        for (int ai = 0; ai < 2; ++ai)
#pragma unroll
            for (int m = 0; m < 4; ++m) { f32x4 v[2];
#pragma unroll
                for (int n = 0; n < 2; ++n) { const f32x4 g = acc[ai][0][m][n], uu = acc[ai][1][m][n];
#pragma unroll
                    for (int e = 0; e < 4; ++e) { const float ex = __builtin_amdgcn_exp2f(g[e] * -1.4426950408889634f); v[n][e] = g[e] * __builtin_amdgcn_rcpf(1.0f + ex) * uu[e]; } }
                *(u32x4*)(H + (size_t)(row0 + ai * HALF + m * 16) * DFF + col0) = pack8(v[0], v[1]); }
    }
};
struct EpiResid {
    static constexpr bool PERM = false, AFTER_DRAIN = false;
    const float* Xlo; const float* Xhi; float* PRE; float alpha;
    __device__ __forceinline__ void operator()(const f32x4 (&acc)[2][2][4][2], const Unit& u, int wr, int wc, int fr, int fq) const {
        const int row0 = u.pm * BM + wr * 64 + fr, col0 = u.pn * BM + wc * 32 + 4 * fq;
        const float* xb = (u.pm < NPROMPT / BM) ? Xlo : Xhi - (size_t)NPROMPT * DM;
#pragma unroll
        for (int ai = 0; ai < 2; ++ai)
#pragma unroll
            for (int m = 0; m < 4; ++m) { const size_t off = (size_t)(row0 + ai * HALF + m * 16) * DM + col0;
#pragma unroll
                for (int bj = 0; bj < 2; ++bj)
#pragma unroll
                    for (int n = 0; n < 2; ++n) { const f32x4 x = *(const f32x4*)(xb + off + bj * HALF + n * 16); *(f32x4*)(PRE + off + bj * HALF + n * 16) = x * alpha + acc[ai][bj][m][n]; } }
    }
};
struct EpiKVQ {
    static constexpr bool PERM = true, AFTER_DRAIN = false;
    bf16_t *Kp, *Vp, *KS, *VS, *Qb; float *k_prompt, *v_prompt, *k_sample, *v_sample;
    __device__ __forceinline__ void operator()(const f32x4 (&acc)[2][2][4][2], const Unit& u, int wr, int wc, int fr, int fq) const {
        const int sect = u.pn >> 3, row0 = u.pm * BM + wr * 64 + fr, col0 = (u.pn & 7) * BM + wc * 32 + 8 * fq;
        const bool sample = u.pm >= NPROMPT / BM, f32out = u.pm >= (NPROMPT - 512) / BM;
#pragma unroll
        for (int ai = 0; ai < 2; ++ai)
#pragma unroll
            for (int m = 0; m < 4; ++m) { const int row = row0 + ai * HALF + m * 16;
                bf16_t* bp; float* fp = nullptr;
                if (sect == 2) bp = Qb + (size_t)row * DM;
                else if (!sample) { bp = (sect ? Vp : Kp) + (size_t)row * DM; if (f32out) fp = (sect ? v_prompt : k_prompt) + (size_t)(row - (NPROMPT - 512)) * DM; }
                else { const int r = row - NPROMPT; bp = (sect ? VS : KS) + (size_t)((r >> 6) * 576 + 512 + (r & 63)) * DM; fp = (sect ? v_sample : k_sample) + (size_t)r * DM; }
#pragma unroll
                for (int bj = 0; bj < 2; ++bj) { *(u32x4*)(bp + col0 + bj * HALF) = pack8(acc[ai][bj][m][0], acc[ai][bj][m][1]);
                    if (fp) { *(f32x4*)(fp + col0 + bj * HALF) = acc[ai][bj][m][0]; *(f32x4*)(fp + col0 + bj * HALF + 4) = acc[ai][bj][m][1]; } } }
    }
};

template <class Epi, class Sched, bool ALIGN_EPI = false, bool SP2 = false>
__device__ __forceinline__ void gemm_phase(PG8_LAS unsigned char* lds, const Gemm g, const Sched& S, const Epi& E) {
    const int tid = threadIdx.x, wid = __builtin_amdgcn_readfirstlane(tid >> 6), lane = tid & 63, wr = wid >> 2, wc = wid & 3, fr = lane & 15, fq = lane >> 4;
    const int K = g.K, nt = K / BK;
    unsigned voffA[2], voffB[2];
#pragma unroll
    for (int i = 0; i < 2; ++i) { int R, C; stage_rc(tid * 16 + i * 8192, R, C); const int Rb = Epi::PERM ? ((R & ~31) + perm32(R & 31)) : R;
        voffA[i] = (unsigned)(R * K + C) * 2u; voffB[i] = (unsigned)(Rb * K + C) * 2u; }
    const size_t kstep = (size_t)(BK * 2);
    const size_t hstep = (size_t)HALF * K * 2;
    const size_t tstep = 2 * hstep;
    const unsigned ldsw = (unsigned)wid * 1024u;
    const int aoff = lds_byte(wr * 64 + fr, fq * 8), boff = lds_byte(wc * 32 + fr, fq * 8);
#define PG8_SA(b, h) (((b) * 2 + (h)) * HTB)
#define PG8_SB(b, h) ((4 + (b) * 2 + (h)) * HTB)
#define PG8_STAGE(bufoff, gbase, voff) do { _Pragma("unroll") for (int _i = 0; _i < 2; ++_i) \
        __builtin_amdgcn_global_load_lds((const unsigned*)((const char*)(gbase) + (voff)[_i]), (PG8_LAS unsigned*)(lds + (bufoff) + ldsw + _i * 8192), 16, 0, 0); } while (0)
#define PG8_LDA(dst, b, h) do { _Pragma("unroll") for (int m = 0; m < 4; ++m) _Pragma("unroll") for (int k = 0; k < 2; ++k) dst[m][k] = *(const PG8_LAS bf16x8*)(lds + PG8_SA(b, h) + aoff + m * 2048 + k * 1024); } while (0)
#define PG8_LDB(dst, b, h) do { _Pragma("unroll") for (int n = 0; n < 2; ++n) _Pragma("unroll") for (int k = 0; k < 2; ++k) dst[n][k] = *(const PG8_LAS bf16x8*)(lds + PG8_SB(b, h) + boff + n * 2048 + k * 1024); } while (0)
#define PG8_MMA(ai, bj, At, Bt) do { __builtin_amdgcn_s_setprio(1); _Pragma("unroll") for (int m = 0; m < 4; ++m) _Pragma("unroll") for (int n = 0; n < 2; ++n) _Pragma("unroll") for (int k = 0; k < 2; ++k) \
        acc[ai][bj][m][n] = __builtin_amdgcn_mfma_f32_16x16x32_bf16(Bt[n][k], At[m][k], acc[ai][bj][m][n], 0, 0, 0); __builtin_amdgcn_s_setprio(0); } while (0)
#define PG8_WAIT_V(n) asm volatile("s_waitcnt vmcnt(" #n ")" ::: "memory")
#define PG8_WAIT_L(n) asm volatile("s_waitcnt lgkmcnt(" #n ")" ::: "memory")
#define PG8_BAR __builtin_amdgcn_s_barrier()
#define PG8_SCHED __builtin_amdgcn_sched_barrier(0)
    Unit cur, nxt; int ui = 0;
    if (!S.next(0, cur)) return;
    f32x4 acc[2][2][4][2];
#pragma unroll
    for (int a = 0; a < 2; ++a)
#pragma unroll
        for (int b = 0; b < 2; ++b)
#pragma unroll
            for (int m = 0; m < 4; ++m)
#pragma unroll
                for (int n = 0; n < 2; ++n) acc[a][b][m][n] = (f32x4){0.f, 0.f, 0.f, 0.f};
    bf16x8 At[4][2], B0[2][2], B1[2][2];
    const char* cA = (const char*)g.A + (size_t)cur.pm * tstep; const char* cB = (const char*)g.Bt + (size_t)cur.pn * tstep;
    S.a_ready(cur);
    if constexpr (SP2) {
        PG8_STAGE(PG8_SB(0, 0), cB, voffB); PG8_STAGE(PG8_SB(0, 1), cB + hstep, voffB); PG8_STAGE(PG8_SA(0, 0), cA, voffA); PG8_STAGE(PG8_SA(0, 1), cA + hstep, voffA);
        if (wr == 1) PG8_BAR;
        PG8_WAIT_V(2); PG8_BAR;
        PG8_STAGE(PG8_SB(1, 0), cB + kstep, voffB); PG8_STAGE(PG8_SA(1, 0), cA + kstep, voffA); PG8_STAGE(PG8_SB(1, 1), cB + hstep + kstep, voffB);
        PG8_WAIT_V(6); PG8_BAR;
    } else {
        PG8_STAGE(PG8_SB(0, 0), cB, voffB); PG8_STAGE(PG8_SA(0, 0), cA, voffA); PG8_STAGE(PG8_SB(0, 1), cB + hstep, voffB); PG8_STAGE(PG8_SA(0, 1), cA + hstep, voffA);
        if (wr == 1) PG8_BAR;
        PG8_WAIT_V(4); PG8_BAR;
        PG8_STAGE(PG8_SB(1, 0), cB + kstep, voffB); PG8_STAGE(PG8_SA(1, 0), cA + kstep, voffA); PG8_STAGE(PG8_SB(1, 1), cB + hstep + kstep, voffB);
        PG8_WAIT_V(6); PG8_BAR;
    }
    for (;;) {
        const bool has_next = S.next(ui + 1, nxt);
        const char* nA = has_next ? (const char*)g.A + (size_t)nxt.pm * tstep : cA; const char* nB = has_next ? (const char*)g.Bt + (size_t)nxt.pn * tstep : cB;
        for (int t = 0; t < nt; t += 2) {
            const bool last = (t == nt - 2);
            const char* a1 = cA + (size_t)(t + 1) * kstep;
            const char* a2 = last ? nA : cA + (size_t)(t + 2) * kstep; const char* b2 = last ? nB : cB + (size_t)(t + 2) * kstep;
            const char* a3 = a2 + kstep; const char* b3 = b2 + kstep;
            if (last && has_next) S.a_ready(nxt);
            if constexpr (SP2) {
            PG8_LDB(B0, 0, 0); PG8_LDB(B1, 0, 1); PG8_SCHED; PG8_LDA(At, 0, 0); PG8_STAGE(PG8_SA(1, 1), a1 + hstep, voffA);
            PG8_WAIT_V(8); PG8_WAIT_L(0); PG8_BAR; PG8_MMA(0, 0, At, B0); PG8_MMA(0, 1, At, B1); PG8_BAR; PG8_SCHED;
            PG8_LDA(At, 0, 1); PG8_STAGE(PG8_SB(0, 0), b2, voffB); PG8_STAGE(PG8_SB(0, 1), b2 + hstep, voffB); PG8_STAGE(PG8_SA(0, 0), a2, voffA);
            PG8_WAIT_V(8); PG8_WAIT_L(0); PG8_BAR; PG8_MMA(1, 0, At, B0); PG8_MMA(1, 1, At, B1); PG8_BAR; PG8_SCHED;
            PG8_LDB(B0, 1, 0); PG8_LDB(B1, 1, 1); PG8_SCHED; PG8_LDA(At, 1, 0); PG8_STAGE(PG8_SA(0, 1), a2 + hstep, voffA);
            PG8_WAIT_V(8); PG8_WAIT_L(0); PG8_BAR; PG8_MMA(0, 0, At, B0); PG8_MMA(0, 1, At, B1); PG8_BAR; PG8_SCHED;
            PG8_LDA(At, 1, 1); PG8_STAGE(PG8_SB(1, 0), b3, voffB); PG8_STAGE(PG8_SB(1, 1), b3 + hstep, voffB); PG8_STAGE(PG8_SA(1, 0), a3, voffA);
            PG8_WAIT_V(8); PG8_WAIT_L(0); PG8_BAR; PG8_MMA(1, 0, At, B0); PG8_MMA(1, 1, At, B1); PG8_BAR; PG8_SCHED;
            } else {
            PG8_LDB(B0, 0, 0); PG8_SCHED; PG8_LDA(At, 0, 0); PG8_STAGE(PG8_SA(1, 1), a1 + hstep, voffA);
            PG8_WAIT_L(8); PG8_BAR; PG8_WAIT_L(0); PG8_MMA(0, 0, At, B0); PG8_BAR; PG8_SCHED;
            PG8_LDB(B1, 0, 1); PG8_STAGE(PG8_SB(0, 0), b2, voffB);
            PG8_BAR; PG8_WAIT_L(0); PG8_MMA(0, 1, At, B1); PG8_BAR;
            PG8_LDA(At, 0, 1); PG8_STAGE(PG8_SA(0, 0), a2, voffA);
            PG8_BAR; PG8_WAIT_L(0); PG8_MMA(1, 0, At, B0); PG8_BAR; PG8_SCHED;
            PG8_STAGE(PG8_SB(0, 1), b2 + hstep, voffB);
            PG8_WAIT_V(6); PG8_BAR; PG8_MMA(1, 1, At, B1); PG8_BAR;
            PG8_LDB(B0, 1, 0); PG8_SCHED; PG8_LDA(At, 1, 0); PG8_STAGE(PG8_SA(0, 1), a2 + hstep, voffA);
            PG8_WAIT_L(8); PG8_BAR; PG8_WAIT_L(0); PG8_MMA(0, 0, At, B0); PG8_BAR; PG8_SCHED;
            PG8_LDB(B1, 1, 1); PG8_STAGE(PG8_SB(1, 0), b3, voffB);
            PG8_BAR; PG8_WAIT_L(0); PG8_MMA(0, 1, At, B1); PG8_BAR;
            PG8_LDA(At, 1, 1); PG8_STAGE(PG8_SA(1, 0), a3, voffA);
            PG8_BAR; PG8_WAIT_L(0); PG8_MMA(1, 0, At, B0); PG8_BAR; PG8_SCHED;
            PG8_STAGE(PG8_SB(1, 1), b3 + hstep, voffB);
            PG8_WAIT_V(6); PG8_BAR; PG8_MMA(1, 1, At, B1); PG8_BAR;
            }
        }
        if constexpr (ALIGN_EPI) { if (wr == 0) PG8_BAR; }
        if constexpr (!Epi::AFTER_DRAIN) { E(acc, cur, wr, wc, fr, fq); S.done(cur); }
        if (!has_next) break;
#pragma unroll
        for (int a = 0; a < 2; ++a)
#pragma unroll
            for (int b = 0; b < 2; ++b)
#pragma unroll
                for (int m = 0; m < 4; ++m)
#pragma unroll
                    for (int n = 0; n < 2; ++n) acc[a][b][m][n] = (f32x4){0.f, 0.f, 0.f, 0.f};
        cur = nxt; cA = nA; cB = nB; ++ui;
        if constexpr (ALIGN_EPI) { if (wr == 1) PG8_BAR; }
    }
    PG8_WAIT_V(0);
    if constexpr (!ALIGN_EPI) { if (wr == 0) PG8_BAR; }
    PG8_BAR;
    if constexpr (Epi::AFTER_DRAIN) { E.fused(acc, cur, wr, wc, fr, fq, lds, wid, lane); S.done(cur); }
#undef PG8_SA
#undef PG8_SB
#undef PG8_STAGE
#undef PG8_LDA
#undef PG8_LDB
#undef PG8_MMA
#undef PG8_WAIT_V
#undef PG8_WAIT_L
#undef PG8_BAR
#undef PG8_SCHED
}
}
#define GAS __attribute__((address_space(1)))
#define LAS __attribute__((address_space(3)))
typedef unsigned short bf16;
typedef unsigned v4u __attribute__((ext_vector_type(4)));
typedef float f32x4 __attribute__((ext_vector_type(4)));
typedef short bf16x8 __attribute__((ext_vector_type(8)));
typedef GAS unsigned gu32;
typedef GAS unsigned long long gu64;
#define RLX_AGENT __ATOMIC_RELAXED, __HIP_MEMORY_SCOPE_AGENT
#define LDS_WAIT() asm volatile("s_waitcnt lgkmcnt(0)" ::: "memory")
#define VM_WAIT() asm volatile("s_waitcnt vmcnt(0)" ::: "memory")
__device__ __forceinline__ unsigned long long rt() { return __builtin_amdgcn_s_memrealtime(); }
__device__ __forceinline__ unsigned f2bf(float f) { unsigned u = __builtin_bit_cast(unsigned, f); return (u + 0x7fffu + ((u >> 16) & 1u)) >> 16; }
__device__ __forceinline__ unsigned pk2(float lo, float hi) { return f2bf(lo) | (f2bf(hi) << 16); }

#define XB_TMO      128
#define XB_XCNT(j)  (256  + 64 * (j))
#define XB_XSUB(j)  (1280 + 64 * (j))
#define XB_XGEN(j)  (2304 + 64 * (j))
#define XB_TOP      3328
#define XB_TOPGEN   3392
#define XCD_BAR_WORDS 3456
#define XB_SPIN_CAP (1u << 18)

__device__ __forceinline__ unsigned xb_ld(unsigned* p)              { return __hip_atomic_load(p, __ATOMIC_RELAXED, __HIP_MEMORY_SCOPE_AGENT); }
__device__ __forceinline__ unsigned xb_add(unsigned* p, unsigned v) { return __hip_atomic_fetch_add(p, v, __ATOMIC_RELAXED, __HIP_MEMORY_SCOPE_AGENT); }
__device__ __forceinline__ unsigned xb_xcc_id() { return (unsigned)__builtin_amdgcn_s_getreg((3 << 11) | 20) & 0xFu; }
#define XB_SPIN(cond, bar) do { unsigned _sp = 0; while (cond) { __builtin_amdgcn_s_sleep(1); \
    if ((++_sp & 255u) == 0u) { if (xb_ld(&(bar)[XB_TMO])) break; if (_sp > XB_SPIN_CAP) { atomicAdd(&(bar)[XB_TMO], 1u); break; } } } } while (0)

struct XcdBarrier {
    unsigned* bar; unsigned x;
    volatile LAS unsigned* st;
};

__device__ __forceinline__ XcdBarrier xcd_barrier_post(unsigned* bar, volatile LAS unsigned* st) {
    XcdBarrier b; b.bar = bar; b.x = xb_xcc_id(); b.st = st;
    if (threadIdx.x == 0) (void)xb_add(&bar[XB_XCNT(b.x)], 1u);
    return b;
}
__device__ __forceinline__ void xcd_barrier_complete(unsigned* bar, unsigned x, unsigned& nloc, unsigned& nx) {
    const unsigned G = gridDim.x * gridDim.y * gridDim.z;
    unsigned sum, cnt, mine, sp = 0u;
    for (;;) {
        sum = 0u; cnt = 0u; mine = 0u;
#pragma unroll
        for (unsigned j = 0; j < 16; ++j) { const unsigned c = xb_ld(&bar[XB_XCNT(j)]); sum += c; cnt += (c > 0u) ? 1u : 0u; mine = (j == x) ? c : mine; }
        if (sum == G) break;
        __builtin_amdgcn_s_sleep(1);
        if ((++sp & 255u) == 0u) { if (xb_ld(&bar[XB_TMO])) break; if (sp > XB_SPIN_CAP) { atomicAdd(&bar[XB_TMO], 1u); break; } }
    }
    nloc = mine > 0u ? mine : 1u; nx = cnt > 0u ? cnt : 1u;
}

__device__ __forceinline__ void xcd_barrier(const XcdBarrier& b) {
    asm volatile("s_waitcnt vmcnt(0)" ::: "memory");
    __syncthreads();
    if (threadIdx.x == 0) {
        unsigned* bar = b.bar;
        __builtin_amdgcn_s_waitcnt(0);
        unsigned nloc = b.st[0], nx = b.st[1];
        if (nloc == 0u) { xcd_barrier_complete(bar, b.x, nloc, nx); b.st[0] = nloc; b.st[1] = nx; }
        const unsigned old = xb_add(&bar[XB_XSUB(b.x)], 1u);
        const unsigned gen = old / nloc;
        if (old + 1u == (gen + 1u) * nloc) {
            __builtin_amdgcn_fence(__ATOMIC_RELEASE, "agent");
            asm volatile("s_waitcnt vmcnt(0)" ::: "memory");
            const unsigned og = xb_add(&bar[XB_TOP], 1u);
            const unsigned tg = og / nx;
            if (og + 1u == (tg + 1u) * nx) xb_add(&bar[XB_TOPGEN], 1u);
            else XB_SPIN(xb_ld(&bar[XB_TOPGEN]) == tg, bar);
            __builtin_amdgcn_fence(__ATOMIC_ACQUIRE, "agent");
            xb_add(&bar[XB_XGEN(b.x)], 1u);
            asm volatile("s_waitcnt vmcnt(0)" ::: "memory");
        } else {
            XB_SPIN(xb_ld(&bar[XB_XGEN(b.x)]) == gen, bar);
            __builtin_amdgcn_fence(__ATOMIC_ACQUIRE, "agent");
            asm volatile("s_waitcnt vmcnt(0)" ::: "memory");
        }
    }
    __syncthreads();
}
constexpr int NWAVES = 8;
constexpr int D = 2048, FF = 5632, NP = 8192, NS = 1024, M = NP + NS, NHEAD = 16, HD = 128, NREL = 513, BAND = 576;
constexpr float LN_EPS = 1e-5f, ALPHA = 1.4142135623730951f  ;
constexpr size_t MiB = 1u << 20;
constexpr size_t WS_CTL = 0, CTL_ZERO_BYTES = 64 * 1024;
constexpr size_t WS_WIN = 2 * MiB, WS_WOUT = 26 * MiB, WS_WKVQ = 34 * MiB, WS_WO = 58 * MiB, WS_WGU0 = 66 * MiB, WS_WGU1 = 110 * MiB, WS_WD0 = 154 * MiB, WS_WD1 = 176 * MiB;
constexpr size_t WS_XB = 198 * MiB, WS_PRE = 234 * MiB, WS_X = 306 * MiB, WS_KS = 378 * MiB, WS_VS = 414 * MiB, WS_UNI = 450 * MiB, WS_END = 594 * MiB;
constexpr size_t WS_BB = WS_UNI, WS_UB = WS_UNI + 36 * MiB, WS_A2 = WS_UNI + 72 * MiB;
constexpr size_t WS_KP = WS_UNI, WS_VP = WS_UNI + 36 * MiB, WS_QB = WS_UNI + 72 * MiB, WS_ATT = WS_UNI + 108 * MiB;
constexpr size_t WS_H = WS_UNI;
constexpr int CW_BAR = 1024;
constexpr int RING_OFF = 0, RING_BYTES = 131072, LDSCTL_OFF = 135168, MISC_OFF = LDSCTL_OFF + 320, LDS_BYTES = 147456;


struct Frame {
    LAS unsigned char* lds; volatile LAS unsigned* MISC; gu32* ctl;
    int tid, lane, wave, vcu, G;
};

__device__ __forceinline__ float wave_sum(float v) {
#pragma unroll
    for (int o = 1; o < 64; o <<= 1) v += __shfl_xor(v, o);
    return v;
}

__device__ __forceinline__ int dest_row(int mode, int row_off, int n) {
    if (mode == 1) { if (n < 2048) return n; if (n < 4096) { const int j = n - 2048; return 2048 + 256 * (j >> 7) + (j & 127); } const int j = n - 4096; return 2048 + 256 * (j >> 7) + 128 + (j & 127); }
    if (mode == 2) { if (n < 5632) return 256 * (n >> 7) + (n & 127); const int j = n - 5632; return 256 * (j >> 7) + 128 + (j & 127); }
    return row_off + n;
}
__device__ __forceinline__ void p0_transpose_item(const float* W, int K, int N, bf16* WT, int mode, int row_off, LAS float* scr, int item, int lane) {
    const int nblk = N >> 6, kb = item / nblk, nb = item - kb * nblk, k0 = 64 * kb, n0 = 64 * nb;
    const int lr = lane >> 4, lc = (lane & 15) * 4;
#pragma unroll 4
    for (int i = 0; i < 16; ++i) { const int kk = 4 * i + lr; const f32x4 v = *(const GAS f32x4*)(W + (size_t)(k0 + kk) * N + n0 + lc);
        LAS float* s = scr + kk * 65 + lc; s[0] = v.x; s[1] = v.y; s[2] = v.z; s[3] = v.w; }
    LDS_WAIT(); asm volatile("" ::: "memory");
    const int c = lane & 7, d0 = dest_row(mode, row_off, n0);
#pragma unroll
    for (int j = 0; j < 8; ++j) { const int n = (lane >> 3) + 8 * j; const LAS float* s = scr + (8 * c) * 65 + n;
        v4u o; o.x = pk2(s[0 * 65], s[1 * 65]); o.y = pk2(s[2 * 65], s[3 * 65]); o.z = pk2(s[4 * 65], s[5 * 65]); o.w = pk2(s[6 * 65], s[7 * 65]);
        *(GAS v4u*)(WT + (size_t)(d0 + n) * K + k0 + 8 * c) = o; }
    LDS_WAIT(); asm volatile("" ::: "memory");
}
__device__ __forceinline__ void cvt_rows(const float* src, bf16* dst, int nrows, int srows, int drows, int doff, int gt, int NGT) {
    for (int i = gt; i < nrows * 256; i += NGT) { const int r = i >> 8, c = (i & 255) * 8;
        const f32x4 a = *(const GAS f32x4*)(src + (size_t)r * D + c), b = *(const GAS f32x4*)(src + (size_t)r * D + c + 4);
        v4u o; o.x = pk2(a.x, a.y); o.y = pk2(a.z, a.w); o.z = pk2(b.x, b.y); o.w = pk2(b.z, b.w);
        const int dr = (r / srows) * drows + doff + (r % srows);
        *(GAS v4u*)(dst + (size_t)dr * D + c) = o; }
}
struct Ptrs {
    const float *x_prompt, *x_sample, *state_conv, *cache_k, *cache_v, *w_in_a, *conv_w, *w_out_a, *w_kv, *w_q, *w_o, *rel_bias, *ln_g, *ln_b, *w_gate_up, *w_down;
    float* out; unsigned char* ws;
};
__device__ __forceinline__ void p0_prologue(Frame& F, const Ptrs& P) {
    LAS float* scr = (LAS float*)(F.lds + RING_OFF) + F.wave * (64 * 65);
    const int gw = F.vcu * NWAVES + F.wave, NGW = F.G * NWAVES;
    unsigned char* ws = P.ws;
    constexpr int I_IN = (D / 64) * (3 * D / 64), I_SQ = (D / 64) * (D / 64), I_KV = (D / 64) * (2 * D / 64), I_GU = (D / 64) * (2 * FF / 64), I_DN = (FF / 64) * (D / 64);
    constexpr int NITEMS = I_IN + 3 * I_SQ + I_KV + 2 * I_GU + 2 * I_DN;
    for (int it = gw; it < NITEMS; it += NGW) {
        int r = it;
        if (r < I_IN) { p0_transpose_item(P.w_in_a, D, 3 * D, (bf16*)(ws + WS_WIN), 1, 0, scr, r, F.lane); continue; } r -= I_IN;
        if (r < I_SQ) { p0_transpose_item(P.w_out_a, D, D, (bf16*)(ws + WS_WOUT), 0, 0, scr, r, F.lane); continue; } r -= I_SQ;
        if (r < I_KV) { p0_transpose_item(P.w_kv, D, 2 * D, (bf16*)(ws + WS_WKVQ), 0, 0, scr, r, F.lane); continue; } r -= I_KV;
        if (r < I_SQ) { p0_transpose_item(P.w_q, D, D, (bf16*)(ws + WS_WKVQ), 0, 2 * D, scr, r, F.lane); continue; } r -= I_SQ;
        if (r < I_SQ) { p0_transpose_item(P.w_o, D, D, (bf16*)(ws + WS_WO), 0, 0, scr, r, F.lane); continue; } r -= I_SQ;
        if (r < I_GU) { p0_transpose_item(P.w_gate_up, D, 2 * FF, (bf16*)(ws + WS_WGU0), 2, 0, scr, r, F.lane); continue; } r -= I_GU;
        if (r < I_GU) { p0_transpose_item(P.w_gate_up + (size_t)D * 2 * FF, D, 2 * FF, (bf16*)(ws + WS_WGU1), 2, 0, scr, r, F.lane); continue; } r -= I_GU;
        if (r < I_DN) { p0_transpose_item(P.w_down, FF, D, (bf16*)(ws + WS_WD0), 0, 0, scr, r, F.lane); continue; } r -= I_DN;
        p0_transpose_item(P.w_down + (size_t)FF * D, FF, D, (bf16*)(ws + WS_WD1), 0, 0, scr, r, F.lane);
    }
    const int gt = (F.vcu * NWAVES + F.wave) * 64 + F.lane, NGT = F.G * NWAVES * 64;
    cvt_rows(P.x_prompt, (bf16*)(ws + WS_XB), NP, NP, NP, 0, gt, NGT);
    cvt_rows(P.x_sample, (bf16*)(ws + WS_XB) + (size_t)NP * D, NS, NS, NS, 0, gt, NGT);
    cvt_rows(P.cache_k, (bf16*)(ws + WS_KS), 16 * 512, 512, BAND, 0, gt, NGT);
    cvt_rows(P.cache_v, (bf16*)(ws + WS_VS), 16 * 512, 512, BAND, 0, gt, NGT);
}

__device__ __forceinline__ void unpack8(const v4u w, float (&f)[8]) {
#pragma unroll
    for (int i = 0; i < 4; ++i) { f[2 * i] = __builtin_bit_cast(float, w[i] << 16); f[2 * i + 1] = __builtin_bit_cast(float, w[i] & 0xffff0000u); }
}
__device__ __forceinline__ void conv_phase(Frame& F, const Ptrs& P) {
    const bf16* Bb = (const bf16*)(P.ws + WS_BB); const bf16* Ub = (const bf16*)(P.ws + WS_UB); bf16* A2 = (bf16*)(P.ws + WS_A2);
    const int gt = (F.vcu * NWAVES + F.wave) * 64 + F.lane, NGT = F.G * NWAVES * 64;
    for (int i = gt; i < M * 256; i += NGT) { const int row = i >> 8, c = (i & 255) * 8;
        const int t = row < NP ? row : (row & 63);
        float b[8], u2[8], u1[8], u0[8], w0[8], w1[8], w2[8];
        unpack8(*(const GAS v4u*)(Bb + (size_t)row * D + c), b); unpack8(*(const GAS v4u*)(Ub + (size_t)row * D + c), u2);
        const float* hist = (row < NP) ? nullptr : P.state_conv + (size_t)((row - NP) >> 6) * 2 * D + c;
        if (t >= 1) unpack8(*(const GAS v4u*)(Ub + (size_t)(row - 1) * D + c), u1);
        else { if (hist) { const f32x4 a = *(const GAS f32x4*)(hist + D), bb = *(const GAS f32x4*)(hist + D + 4); u1[0] = a.x; u1[1] = a.y; u1[2] = a.z; u1[3] = a.w; u1[4] = bb.x; u1[5] = bb.y; u1[6] = bb.z; u1[7] = bb.w; }
               else {
#pragma unroll
                   for (int e = 0; e < 8; ++e) u1[e] = 0.f; } }
        if (t >= 2) unpack8(*(const GAS v4u*)(Ub + (size_t)(row - 2) * D + c), u0);
        else { if (hist) { const float* hp = hist + t * D; const f32x4 a = *(const GAS f32x4*)(hp), bb = *(const GAS f32x4*)(hp + 4); u0[0] = a.x; u0[1] = a.y; u0[2] = a.z; u0[3] = a.w; u0[4] = bb.x; u0[5] = bb.y; u0[6] = bb.z; u0[7] = bb.w; }
               else {
#pragma unroll
                   for (int e = 0; e < 8; ++e) u0[e] = 0.f; } }
        { const f32x4 a = *(const GAS f32x4*)(P.conv_w + c), bb = *(const GAS f32x4*)(P.conv_w + c + 4); w0[0] = a.x; w0[1] = a.y; w0[2] = a.z; w0[3] = a.w; w0[4] = bb.x; w0[5] = bb.y; w0[6] = bb.z; w0[7] = bb.w; }
        { const f32x4 a = *(const GAS f32x4*)(P.conv_w + D + c), bb = *(const GAS f32x4*)(P.conv_w + D + c + 4); w1[0] = a.x; w1[1] = a.y; w1[2] = a.z; w1[3] = a.w; w1[4] = bb.x; w1[5] = bb.y; w1[6] = bb.z; w1[7] = bb.w; }
        { const f32x4 a = *(const GAS f32x4*)(P.conv_w + 2 * D + c), bb = *(const GAS f32x4*)(P.conv_w + 2 * D + c + 4); w2[0] = a.x; w2[1] = a.y; w2[2] = a.z; w2[3] = a.w; w2[4] = bb.x; w2[5] = bb.y; w2[6] = bb.z; w2[7] = bb.w; }
        float r[8];
#pragma unroll
        for (int e = 0; e < 8; ++e) r[e] = b[e] * (w0[e] * u0[e] + w1[e] * u1[e] + w2[e] * u2[e]);
        v4u o; o.x = pk2(r[0], r[1]); o.y = pk2(r[2], r[3]); o.z = pk2(r[4], r[5]); o.w = pk2(r[6], r[7]);
        *(GAS v4u*)(A2 + (size_t)row * D + c) = o; }
}

__device__ __forceinline__ void ln_phase(Frame& F, const float* PRE, const float* g, const float* b, float* Xout, bf16* XBout) {
    const int gw = F.vcu * NWAVES + F.wave, NGW = F.G * NWAVES;
    for (int row = gw; row < M; row += NGW) {
        const GAS f32x4* xr = (const GAS f32x4*)(PRE + (size_t)row * D) + F.lane;
        f32x4 v[8]; float s = 0.f;
#pragma unroll
        for (int j = 0; j < 8; ++j) { v[j] = xr[64 * j]; s += (v[j].x + v[j].y) + (v[j].z + v[j].w); }
        const float mean = wave_sum(s) * (1.f / D); float s2 = 0.f;
#pragma unroll
        for (int j = 0; j < 8; ++j) { v[j] = v[j] - mean; s2 += (v[j].x * v[j].x + v[j].y * v[j].y) + (v[j].z * v[j].z + v[j].w * v[j].w); }
        const float rstd = 1.f / sqrtf(wave_sum(s2) * (1.f / D) + LN_EPS);
        GAS f32x4* o4 = (GAS f32x4*)(Xout + (size_t)row * D) + F.lane;
        const GAS f32x4* g4 = (const GAS f32x4*)g + F.lane; const GAS f32x4* b4 = (const GAS f32x4*)b + F.lane;
#pragma unroll
        for (int j = 0; j < 8; ++j) { const f32x4 y = v[j] * rstd * g4[64 * j] + b4[64 * j]; o4[64 * j] = y;
            if (XBout) { GAS unsigned long long* o8 = (GAS unsigned long long*)(XBout + (size_t)row * D) + F.lane; o8[64 * j] = (unsigned long long)pk2(y.x, y.y) | ((unsigned long long)pk2(y.z, y.w) << 32); } }
    }
}

namespace att {
typedef short s16x4 __attribute__((ext_vector_type(4)));
constexpr int PITCH = 272, HEADB = 64 * PITCH, KOFF = 0, VOFF = 2 * HEADB, BOFF = 4 * HEADB, TBN = 520;
static_assert(BOFF + 2 * TBN * 4 <= RING_BYTES, "attention LDS");
__device__ __forceinline__ s16x4 vtr(const LAS unsigned char* p) { return __builtin_bit_cast(s16x4, __builtin_amdgcn_ds_read_tr16_b64_v4i16((LAS s16x4*)p)); }
__device__ __forceinline__ void attn_phase(Frame& F, const Ptrs& P) {
    const bf16* Qb = (const bf16*)(P.ws + WS_QB); const bf16* Kp = (const bf16*)(P.ws + WS_KP); const bf16* Vp = (const bf16*)(P.ws + WS_VP);
    const bf16* KS = (const bf16*)(P.ws + WS_KS); const bf16* VS = (const bf16*)(P.ws + WS_VS); bf16* ATT = (bf16*)(P.ws + WS_ATT);
    LAS unsigned char* lds = F.lds + RING_OFF;
    const int tid = F.tid, lane = F.lane, wid = F.wave, fr = lane & 15, fq = lane >> 4;
    const int hl = wid >> 2, qs = (wid & 3) * 16, qi = qs + fr;
    LAS float* tb = (LAS float*)(lds + BOFF);
    const float C = 0.08838834764831845f * 1.4426950408889634f;
    for (int unit = F.vcu; unit < 144 * 8; unit += F.G) {
        const int hp = unit & 7, cidx = unit >> 3, hh = hp * 2 + hl;
        int qrow0, t0, krow_base; const bf16 *Kb, *Vb;
        if (cidx < 128) { qrow0 = 64 * cidx; t0 = cidx < 8 ? 8 - cidx : 0; Kb = Kp; Vb = Vp; krow_base = 64 * (cidx - 8); }
        else { const int n = cidx - 128; qrow0 = NP + 64 * n; t0 = 0; Kb = KS; Vb = VS; krow_base = BAND * n; }
        __syncthreads();
        for (int i = tid; i < 2 * NREL; i += NWAVES * 64) { const int h2 = i >= NREL ? 1 : 0, r = i - h2 * NREL; tb[h2 * TBN + r] = P.rel_bias[(size_t)(hp * 2 + h2) * NREL + r] * 1.4426950408889634f; }
        bf16x8 qf[4];
        { const bf16* qp = Qb + (size_t)(qrow0 + qi) * D + hh * HD + fq * 8;
#pragma unroll
          for (int s = 0; s < 4; ++s) qf[s] = *(const GAS bf16x8*)(qp + s * 32); }
        v4u kreg[4], vreg[4];
        const int lkey = tid >> 5, lch = tid & 31;
        const unsigned ldst = (unsigned)((lch >> 4) * HEADB + lkey * PITCH + (lch & 15) * 16);
#define AT_LOAD(t) do { const size_t ro_ = (size_t)(krow_base + 64 * (t) + lkey) * D + hp * 256 + lch * 8; \
        _Pragma("unroll") for (int p_ = 0; p_ < 4; ++p_) { kreg[p_] = *(const GAS v4u*)(Kb + ro_ + (size_t)p_ * 16 * D); vreg[p_] = *(const GAS v4u*)(Vb + ro_ + (size_t)p_ * 16 * D); } } while (0)
        AT_LOAD(t0);
        float mrun = -INFINITY, lrun = 0.f; f32x4 o[8];
#pragma unroll
        for (int dt = 0; dt < 8; ++dt) o[dt] = (f32x4){0.f, 0.f, 0.f, 0.f};
        const LAS unsigned char* kfb = lds + KOFF + hl * HEADB + fr * PITCH + fq * 16;
        const LAS unsigned char* vfb = lds + VOFF + hl * HEADB + (4 * fq + (fr >> 2)) * PITCH + (fr & 3) * 8;
        for (int t = t0; t < 9; ++t) {
            __syncthreads();
#pragma unroll
            for (int p = 0; p < 4; ++p) { *(LAS v4u*)(lds + KOFF + ldst + p * 16 * PITCH) = kreg[p]; *(LAS v4u*)(lds + VOFF + ldst + p * 16 * PITCH) = vreg[p]; }
            __syncthreads();
            if (t + 1 < 9) AT_LOAD(t + 1);
            f32x4 sc[4];
#pragma unroll
            for (int s = 0; s < 4; ++s) { f32x4 a = (f32x4){0.f, 0.f, 0.f, 0.f};
#pragma unroll
                for (int st = 0; st < 4; ++st) { const bf16x8 kf = *(const LAS bf16x8*)(kfb + s * 16 * PITCH + st * 64); a = __builtin_amdgcn_mfma_f32_16x16x32_bf16(kf, qf[st], a, 0, 0, 0); }
                sc[s] = a; }
            float tmax = -INFINITY;
#pragma unroll
            for (int s = 0; s < 4; ++s)
#pragma unroll
                for (int r = 0; r < 4; ++r) { const int jb = 64 * t + 16 * s + 4 * fq + r; int rel = 512 + qi - jb; rel = rel > 256 ? 256 : (rel < -256 ? -256 : rel);
                    const float v = sc[s][r] * C + tb[hl * TBN + rel + 256]; sc[s][r] = v; tmax = fmaxf(tmax, v); }
            tmax = fmaxf(tmax, __shfl_xor(tmax, 16)); tmax = fmaxf(tmax, __shfl_xor(tmax, 32));
            const float mnew = fmaxf(mrun, tmax), alpha = __builtin_amdgcn_exp2f(mrun - mnew); mrun = mnew;
            float psum = 0.f;
#pragma unroll
            for (int s = 0; s < 4; ++s)
#pragma unroll
                for (int r = 0; r < 4; ++r) { const float p = __builtin_amdgcn_exp2f(sc[s][r] - mnew); sc[s][r] = p; psum += p; }
            lrun = lrun * alpha + psum;
#pragma unroll
            for (int dt = 0; dt < 8; ++dt) o[dt] = o[dt] * alpha;
            bf16x8 pb[2];
#pragma unroll
            for (int ks = 0; ks < 2; ++ks) { const v4u w = {pk2(sc[2 * ks][0], sc[2 * ks][1]), pk2(sc[2 * ks][2], sc[2 * ks][3]), pk2(sc[2 * ks + 1][0], sc[2 * ks + 1][1]), pk2(sc[2 * ks + 1][2], sc[2 * ks + 1][3])}; pb[ks] = __builtin_bit_cast(bf16x8, w); }
#pragma unroll
            for (int dt = 0; dt < 8; ++dt)
#pragma unroll
                for (int ks = 0; ks < 2; ++ks) { const s16x4 va = vtr(vfb + (32 * ks) * PITCH + dt * 32), vb = vtr(vfb + (32 * ks + 16) * PITCH + dt * 32);
                    const bf16x8 vf = {va[0], va[1], va[2], va[3], vb[0], vb[1], vb[2], vb[3]};
                    o[dt] = __builtin_amdgcn_mfma_f32_16x16x32_bf16(vf, pb[ks], o[dt], 0, 0, 0); }
        }
#undef AT_LOAD
        lrun += __shfl_xor(lrun, 16); lrun += __shfl_xor(lrun, 32);
        const float inv = 1.0f / lrun;
        bf16* op = ATT + (size_t)(qrow0 + qi) * D + hh * HD + 4 * fq;
#pragma unroll
        for (int dt = 0; dt < 8; ++dt) { const f32x4 y = o[dt] * inv; *(GAS unsigned long long*)(op + dt * 16) = (unsigned long long)pk2(y.x, y.y) | ((unsigned long long)pk2(y.z, y.w) << 32); }
    }
    __syncthreads();
}
}

#ifndef MK_ONE_LAUNCH
#define MK_ONE_LAUNCH 1
#endif
constexpr int N_PHASES = 15;
struct Args { Ptrs p; int ph_lo, ph_hi; };
__global__ void __launch_bounds__(NWAVES * 64, 2) yoco_fwd(Args args) {
    extern __shared__ __attribute__((aligned(16))) unsigned char lds_raw[];
    Frame F;
    F.lds = (LAS unsigned char*)lds_raw;
    F.MISC = (volatile LAS unsigned*)(F.lds + MISC_OFF);
    F.tid = threadIdx.x; F.lane = F.tid & 63; F.wave = __builtin_amdgcn_readfirstlane(F.tid >> 6);
    F.G = gridDim.x; { const int bx = blockIdx.x; F.vcu = (F.G % 8 == 0) ? (bx % 8) * (F.G / 8) + bx / 8 : bx; }
    const Ptrs& P = args.p;
    unsigned char* ws = P.ws;
    F.ctl = (gu32*)(ws + WS_CTL);
    for (int u = F.tid; u < (LDS_BYTES - LDSCTL_OFF) / 4; u += NWAVES * 64) ((LAS unsigned*)(F.lds + LDSCTL_OFF))[u] = 0u;
    __syncthreads();
#if MK_ONE_LAUNCH
    XcdBarrier bar = xcd_barrier_post((unsigned*)(F.ctl + CW_BAR), F.MISC + 8);
#define GRID_BAR() xcd_barrier(bar)
#else
#define GRID_BAR() do {} while (0)
#endif
    const int lo = args.ph_lo, hi = args.ph_hi;
#define IN(k) (lo <= (k) && (k) < hi)
#define SEAM(k) do { if (IN(k) && IN((k) + 1)) GRID_BAR(); } while (0)
    bf16* XB = (bf16*)(ws + WS_XB); float* PRE = (float*)(ws + WS_PRE); float* X = (float*)(ws + WS_X); bf16* HB = (bf16*)(ws + WS_H);
    float* out = P.out;
    float* y_out = out;
    float* conv_p = out + (size_t)M * D;
    float* conv_s = conv_p + 2 * D;
    float* k_prompt = conv_s + 32 * D;
    float* v_prompt = k_prompt + (size_t)512 * D;
    float* k_sample = v_prompt + (size_t)512 * D;
    float* v_sample = k_sample + (size_t)NS * D;

    if (IN(0)) {
        p0_prologue(F, P);
#if MK_ONE_LAUNCH
        if (IN(1)) { cooperative_groups::this_grid().sync(); }
#endif
    }
    if (IN(1)) {
        pg8::Gemm g{XB, (const bf16*)(ws + WS_WIN), M, 3 * D, D}; pg8::StaticOrder S; S.init(M, 3 * D, F.G, (int)blockIdx.x);
        pg8::EpiInA E{(bf16*)(ws + WS_BB), (bf16*)(ws + WS_UB), conv_p, conv_s};
        pg8::gemm_phase<pg8::EpiInA, pg8::StaticOrder, true, true>(F.lds + RING_OFF, g, S, E);
        SEAM(1);
    }
    if (IN(2)) { conv_phase(F, P); SEAM(2); }
    if (IN(3)) {
        pg8::Gemm g{(const bf16*)(ws + WS_A2), (const bf16*)(ws + WS_WOUT), M, D, D}; pg8::StaticOrder S; S.init(M, D, F.G, (int)blockIdx.x);
        pg8::EpiResid E{P.x_prompt, P.x_sample, PRE, ALPHA};
        pg8::gemm_phase<pg8::EpiResid, pg8::StaticOrder, true, true>(F.lds + RING_OFF, g, S, E);
        SEAM(3);
    }
    if (IN(4)) { ln_phase(F, PRE, P.ln_g + 0 * D, P.ln_b + 0 * D, X, XB); SEAM(4); }
    if (IN(5)) {
        pg8::Gemm g{XB, (const bf16*)(ws + WS_WGU0), M, 2 * FF, D}; pg8::StaticOrder S; S.init(M, 2 * FF, F.G, (int)blockIdx.x);
        pg8::EpiSwiGLU E{HB};
        pg8::gemm_phase<pg8::EpiSwiGLU, pg8::StaticOrder, true, true>(F.lds + RING_OFF, g, S, E);
        SEAM(5);
    }
    if (IN(6)) {
        pg8::Gemm g{HB, (const bf16*)(ws + WS_WD0), M, D, FF}; pg8::StaticOrder S; S.init(M, D, F.G, (int)blockIdx.x);
        pg8::EpiResid E{X, X + (size_t)NP * D, PRE, ALPHA};
        pg8::gemm_phase<pg8::EpiResid, pg8::StaticOrder, true, true>(F.lds + RING_OFF, g, S, E);
        SEAM(6);
    }
    if (IN(7)) { ln_phase(F, PRE, P.ln_g + 1 * D, P.ln_b + 1 * D, X, XB); SEAM(7); }
    if (IN(8)) {
        pg8::Gemm g{XB, (const bf16*)(ws + WS_WKVQ), M, 3 * D, D}; pg8::StaticOrder S; S.init(M, 3 * D, F.G, (int)blockIdx.x);
        pg8::EpiKVQ E{(bf16*)(ws + WS_KP), (bf16*)(ws + WS_VP), (bf16*)(ws + WS_KS), (bf16*)(ws + WS_VS), (bf16*)(ws + WS_QB), k_prompt, v_prompt, k_sample, v_sample};
        pg8::gemm_phase<pg8::EpiKVQ, pg8::StaticOrder, true, true>(F.lds + RING_OFF, g, S, E);
        SEAM(8);
    }
    if (IN(9)) { att::attn_phase(F, P); SEAM(9); }
    if (IN(10)) {
        pg8::Gemm g{(const bf16*)(ws + WS_ATT), (const bf16*)(ws + WS_WO), M, D, D}; pg8::StaticOrder S; S.init(M, D, F.G, (int)blockIdx.x);
        pg8::EpiResid E{X, X + (size_t)NP * D, PRE, ALPHA};
        pg8::gemm_phase<pg8::EpiResid, pg8::StaticOrder, true, true>(F.lds + RING_OFF, g, S, E);
        SEAM(10);
    }
    if (IN(11)) { ln_phase(F, PRE, P.ln_g + 2 * D, P.ln_b + 2 * D, X, XB); SEAM(11); }
    if (IN(12)) {
        pg8::Gemm g{XB, (const bf16*)(ws + WS_WGU1), M, 2 * FF, D}; pg8::StaticOrder S; S.init(M, 2 * FF, F.G, (int)blockIdx.x);
        pg8::EpiSwiGLU E{HB};
        pg8::gemm_phase<pg8::EpiSwiGLU, pg8::StaticOrder, true, true>(F.lds + RING_OFF, g, S, E);
        SEAM(12);
    }
    if (IN(13)) {
        pg8::Gemm g{HB, (const bf16*)(ws + WS_WD1), M, D, FF}; pg8::StaticOrder S; S.init(M, D, F.G, (int)blockIdx.x);
        pg8::EpiResid E{X, X + (size_t)NP * D, PRE, ALPHA};
        pg8::gemm_phase<pg8::EpiResid, pg8::StaticOrder, true, true>(F.lds + RING_OFF, g, S, E);
        SEAM(13);
    }
    if (IN(14)) { ln_phase(F, PRE, P.ln_g + 3 * D, P.ln_b + 3 * D, y_out, nullptr); }
#undef IN
#undef SEAM
}

extern "C" void kernel_launch(void* const* d_in, const int* in_sizes, int n_in, void* d_out, int out_size, void* d_ws, size_t ws_size, hipStream_t stream) {
    static int grid = 0;
    if (grid == 0) {
        if (n_in != 16 || ws_size < WS_END) { fprintf(stderr, "kernel_launch: unexpected n_in %d / ws_size %zu (need %zu)\n", n_in, ws_size, (size_t)WS_END); grid = -1; return; }
        int dev = 0, cus = 0, per_cu = 0;
        if (hipGetDevice(&dev) != hipSuccess || hipDeviceGetAttribute(&cus, hipDeviceAttributeMultiprocessorCount, dev) != hipSuccess) { grid = -1; return; }
        if (hipFuncSetAttribute((const void*)yoco_fwd, hipFuncAttributeMaxDynamicSharedMemorySize, LDS_BYTES) != hipSuccess) { fprintf(stderr, "kernel_launch: hipFuncSetAttribute failed\n"); grid = -1; return; }
        if (hipOccupancyMaxActiveBlocksPerMultiprocessor(&per_cu, (const void*)yoco_fwd, NWAVES * 64, LDS_BYTES) != hipSuccess || per_cu < 1) { fprintf(stderr, "kernel_launch: occupancy query says %d\n", per_cu); per_cu = 1; }
        (void)hipGetLastError();
        grid = cus;
        if (grid > cus * per_cu) grid = cus * per_cu;
        grid &= ~7;
    }
    if (grid <= 0) return;
    Args a{};
    const float* const* in = (const float* const*)d_in;
    a.p.x_prompt = in[0]; a.p.x_sample = in[1]; a.p.state_conv = in[2]; a.p.cache_k = in[3]; a.p.cache_v = in[4]; a.p.w_in_a = in[5]; a.p.conv_w = in[6]; a.p.w_out_a = in[7];
    a.p.w_kv = in[8]; a.p.w_q = in[9]; a.p.w_o = in[10]; a.p.rel_bias = in[11]; a.p.ln_g = in[12]; a.p.ln_b = in[13]; a.p.w_gate_up = in[14]; a.p.w_down = in[15];
    a.p.out = (float*)d_out; a.p.ws = (unsigned char*)d_ws;
#if MK_ONE_LAUNCH
    if (hipMemsetAsync((char*)d_ws + WS_CTL, 0, CTL_ZERO_BYTES, stream) != hipSuccess) { fprintf(stderr, "kernel_launch: memset failed\n"); return; }
    a.ph_lo = 0; a.ph_hi = N_PHASES;
    void* kargs[] = {&a};
    hipError_t e = hipLaunchCooperativeKernel((const void*)yoco_fwd, dim3(grid), dim3(NWAVES * 64), kargs, LDS_BYTES, stream);
    if (e != hipSuccess) fprintf(stderr, "kernel_launch: cooperative launch failed: %s (grid %d)\n", hipGetErrorString(e), grid);
#else
    for (int ph = 0; ph < N_PHASES; ++ph) { a.ph_lo = ph; a.ph_hi = ph + 1; hipLaunchKernelGGL(yoco_fwd, dim3(grid), dim3(NWAVES * 64), LDS_BYTES, stream, a); }
#endif
}
```

```cpp
#include <hip/hip_runtime.h>
#include <hip/hip_cooperative_groups.h>
#include <cstdio>
#include <cstdint>
#include <cmath>
namespace pg8 {
#define PG8_LAS __attribute__((address_space(3)))
typedef unsigned short bf16_t;
typedef short bf16x8 __attribute__((ext_vector_type(8)));
typedef float f32x4 __attribute__((ext_vector_type(4)));
typedef unsigned u32x4 __attribute__((ext_vector_type(4)));
constexpr int BM = 256, BK = 64, HALF = 128, HTB = HALF * BK * 2  , STAGE_BYTES = 8 * HTB, NXCD = 8, WGM = 8;

__host__ __device__ __forceinline__ int lds_byte(int r, int c) { const int st = (r >> 4) * 2 + (c >> 5), rr = r & 15, cc = c & 31, ob = rr * 64 + cc * 2; return st * 1024 + (ob ^ (((ob >> 9) & 1) << 5)); }
__host__ __device__ __forceinline__ void stage_rc(int b, int& R, int& C) { const int st = b / 1024, sb = b % 1024, swz = sb ^ (((sb >> 9) & 1) << 5); R = (st >> 1) * 16 + swz / 64; C = (st & 1) * 32 + (swz % 64) / 2; }
__host__ __device__ __forceinline__ int perm32(int rho) { const int n = rho >> 4, i = rho & 15; return 8 * (i >> 2) + 4 * n + (i & 3); }

struct Unit { int pm, pn, k0, nt, ks; };
struct Gemm { const bf16_t* A; const bf16_t* Bt; int M, N, K; };

struct StaticOrder {
    int nM, nN, nwg, G, c, ntk;
    __host__ __device__ void init(int M, int N, int K, int G_, int c_) { nM = M / BM; nN = N / BM; nwg = nM * nN; G = G_; c = c_; ntk = K / BK; }
    __host__ __device__ __forceinline__ bool next(int i, Unit& u) const {
        const long L = (long)i * G + c; if (L >= nwg) return false;
        int wgid = (int)L; { const int q = nwg / NXCD, r = nwg % NXCD, xcd = wgid % NXCD, off = wgid / NXCD; wgid = (xcd < r ? xcd * (q + 1) : r * (q + 1) + (xcd - r) * q) + off; }
        const int nig = WGM * nN, gid = wgid / nig, fm = gid * WGM, gsz = (nM - fm) < WGM ? (nM - fm) : WGM;
        u.pm = fm + ((wgid % nig) % gsz); u.pn = (wgid % nig) / gsz; u.k0 = 0; u.nt = ntk; u.ks = 0; return true;
    }
    __device__ __forceinline__ void a_ready(const Unit&) const {}
    __device__ __forceinline__ void done(const Unit&) const {}
};

struct TailSplitOrder {
    int G, v, ntk;
    __host__ __device__ void init(int K, int G_, int v_) { G = G_; v = v_; ntk = K / BK; }
    __host__ __device__ __forceinline__ bool next(int i, Unit& u) const {
        const int item = (G == 256) ? (i == 0 ? v : ((i == 1 && !(v & 1)) ? 256 + (v >> 1) : 384)) : i * G + v;
        if (item >= 384) return false;
        const bool full = item < 256; const int j = item - 256, ux = j >> 2;
        const int ks = full ? 0 : (j & 3), nt = full ? ntk : (ntk >> 2);
        u.pm = full ? (item >> 3) : 32 + (ux >> 3); u.pn = full ? (item & 7) : (ux & 7); u.ks = ks; u.nt = nt; u.k0 = ks * nt * BK; return true;
    }
    __device__ __forceinline__ void a_ready(const Unit&) const {}
    __device__ __forceinline__ void done(const Unit&) const {}
};

__device__ __forceinline__ unsigned cvt_pk_bf16(float lo, float hi) { unsigned r; asm volatile("v_cvt_pk_bf16_f32 %0, %1, %2" : "=v"(r) : "v"(lo), "v"(hi)); return r; }
typedef float f32x2 __attribute__((ext_vector_type(2)));
typedef unsigned u32x2 __attribute__((ext_vector_type(2)));
constexpr int DM = 2048, DFF = 5632, NPROMPT = 8192;
__device__ __forceinline__ u32x4 pack8(const f32x4 a, const f32x4 b) { u32x4 w; w.x = cvt_pk_bf16(a[0], a[1]); w.y = cvt_pk_bf16(a[2], a[3]); w.z = cvt_pk_bf16(b[0], b[1]); w.w = cvt_pk_bf16(b[2], b[3]); return w; }

struct EpiInA {
    static constexpr bool PERM = true, AFTER_DRAIN = false;
    bf16_t* Bb; bf16_t* Ub; float* conv_p; float* conv_s;
    __device__ __forceinline__ void operator()(const f32x4 (&acc)[2][2][4][2], const Unit& u, int wr, int wc, int fr, int fq) const {
        const int row0 = u.pm * BM + wr * 64 + fr;
        if (u.pn < 8) {
            const int col0 = u.pn * BM + wc * 32 + 8 * fq;
#pragma unroll
            for (int ai = 0; ai < 2; ++ai)
#pragma unroll
                for (int m = 0; m < 4; ++m) { bf16_t* rowp = Bb + (size_t)(row0 + ai * HALF + m * 16) * DM + col0;
#pragma unroll
                    for (int bj = 0; bj < 2; ++bj) *(u32x4*)(rowp + bj * HALF) = pack8(acc[ai][bj][m][0], acc[ai][bj][m][1]); }
        } else {
            const int col0 = (u.pn - 8) * HALF + wc * 32 + 8 * fq;
#pragma unroll
            for (int ai = 0; ai < 2; ++ai)
#pragma unroll
                for (int m = 0; m < 4; ++m) { const int row = row0 + ai * HALF + m * 16;
                    const f32x4 v0 = acc[ai][0][m][0] * acc[ai][1][m][0], v1 = acc[ai][0][m][1] * acc[ai][1][m][1];
                    *(u32x4*)(Ub + (size_t)row * DM + col0) = pack8(v0, v1);
                    if (row >= NPROMPT - 64 && (row & 63) >= 62) {
                        float* dst = (row < NPROMPT) ? conv_p + (size_t)(row - (NPROMPT - 2)) * DM : conv_s + (size_t)((((row - NPROMPT) >> 6) << 1) + (row & 63) - 62) * DM;
                        *(f32x4*)(dst + col0) = v0; *(f32x4*)(dst + col0 + 4) = v1; } }
        }
    }
};
struct EpiSwiGLU {
    static constexpr bool PERM = true, AFTER_DRAIN = false;
    bf16_t* H;
    __device__ __forceinline__ void operator()(const f32x4 (&acc)[2][2][4][2], const Unit& u, int wr, int wc, int fr, int fq) const {
        const int row0 = u.pm * BM + wr * 64 + fr, col0 = u.pn * HALF + wc * 32 + 8 * fq;
#pragma unroll
        for (int ai = 0; ai < 2; ++ai)
#pragma unroll
            for (int m = 0; m < 4; ++m) { f32x4 v[2];
#pragma unroll
                for (int n = 0; n < 2; ++n) { const f32x4 g = acc[ai][0][m][n], uu = acc[ai][1][m][n];
#pragma unroll
                    for (int e = 0; e < 4; ++e) { const float ex = __builtin_amdgcn_exp2f(g[e] * -1.4426950408889634f); v[n][e] = g[e] * __builtin_amdgcn_rcpf(1.0f + ex) * uu[e]; } }
                *(u32x4*)(H + (size_t)(row0 + ai * HALF + m * 16) * DFF + col0) = pack8(v[0], v[1]); }
    }
};
struct EpiResid {
    static constexpr bool PERM = false, AFTER_DRAIN = false;
    const float* Xlo; const float* Xhi; const bf16_t* XBr; float* PRE; float alpha; float* PART;
    __device__ __forceinline__ void operator()(const f32x4 (&acc)[2][2][4][2], const Unit& u, int wr, int wc, int fr, int fq) const {
        const int row0 = u.pm * BM + wr * 64 + fr, col0 = u.pn * BM + wc * 32 + 4 * fq;
        if (u.ks != 0) { float* pp = PART + (size_t)(u.ks - 1) * 1024 * DM - (size_t)NPROMPT * DM;
#pragma unroll
            for (int ai = 0; ai < 2; ++ai)
#pragma unroll
                for (int m = 0; m < 4; ++m) { const size_t off = (size_t)(row0 + ai * HALF + m * 16) * DM + col0;
#pragma unroll
                    for (int bj = 0; bj < 2; ++bj)
#pragma unroll
                        for (int n = 0; n < 2; ++n) *(f32x4*)(pp + off + bj * HALF + n * 16) = acc[ai][bj][m][n]; }
            return; }
        const float* xb = (u.pm < NPROMPT / BM) ? Xlo : Xhi - (size_t)NPROMPT * DM;
#pragma unroll
        for (int ai = 0; ai < 2; ++ai)
#pragma unroll
            for (int m = 0; m < 4; ++m) { const size_t off = (size_t)(row0 + ai * HALF + m * 16) * DM + col0;
#pragma unroll
                for (int bj = 0; bj < 2; ++bj)
#pragma unroll
                    for (int n = 0; n < 2; ++n) { f32x4 x;
                        if (XBr) { const u32x2 w = *(const u32x2*)(XBr + off + bj * HALF + n * 16); x = (f32x4){__builtin_bit_cast(float, w.x << 16), __builtin_bit_cast(float, w.x & 0xffff0000u), __builtin_bit_cast(float, w.y << 16), __builtin_bit_cast(float, w.y & 0xffff0000u)}; }
                        else x = *(const f32x4*)(xb + off + bj * HALF + n * 16);
                        *(f32x4*)(PRE + off + bj * HALF + n * 16) = x * alpha + acc[ai][bj][m][n]; } }
    }
};
struct EpiKVQ {
    static constexpr bool PERM = true, AFTER_DRAIN = false;
    bf16_t *Kp, *Vp, *KS, *VS, *Qb; float *k_prompt, *v_prompt, *k_sample, *v_sample;
    __device__ __forceinline__ void operator()(const f32x4 (&acc)[2][2][4][2], const Unit& u, int wr, int wc, int fr, int fq) const {
        const int sect = u.pn >> 3, row0 = u.pm * BM + wr * 64 + fr, col0 = (u.pn & 7) * BM + wc * 32 + 8 * fq;
        const bool sample = u.pm >= NPROMPT / BM, f32out = u.pm >= (NPROMPT - 512) / BM;
#pragma unroll
        for (int ai = 0; ai < 2; ++ai)
#pragma unroll
            for (int m = 0; m < 4; ++m) { const int row = row0 + ai * HALF + m * 16;
                bf16_t* bp; float* fp = nullptr;
                if (sect == 2) bp = Qb + (size_t)row * DM;
                else if (!sample) { bp = (sect ? Vp : Kp) + (size_t)row * DM; if (f32out) fp = (sect ? v_prompt : k_prompt) + (size_t)(row - (NPROMPT - 512)) * DM; }
                else { const int r = row - NPROMPT; bp = (sect ? VS : KS) + (size_t)((r >> 6) * 576 + 512 + (r & 63)) * DM; fp = (sect ? v_sample : k_sample) + (size_t)r * DM; }
#pragma unroll
                for (int bj = 0; bj < 2; ++bj) { *(u32x4*)(bp + col0 + bj * HALF) = pack8(acc[ai][bj][m][0], acc[ai][bj][m][1]);
                    if (fp) { *(f32x4*)(fp + col0 + bj * HALF) = acc[ai][bj][m][0]; *(f32x4*)(fp + col0 + bj * HALF + 4) = acc[ai][bj][m][1]; } } }
    }
};

template <class Epi, class Sched, bool ALIGN_EPI = false, bool SP2 = false>
__device__ __forceinline__ void gemm_phase(PG8_LAS unsigned char* lds, const Gemm g, const Sched& S, const Epi& E) {
    const int tid = threadIdx.x, wid = __builtin_amdgcn_readfirstlane(tid >> 6), lane = tid & 63, wr = wid >> 2, wc = wid & 3, fr = lane & 15, fq = lane >> 4;
    const int K = g.K;
    unsigned voffA[2], voffB[2];
#pragma unroll
    for (int i = 0; i < 2; ++i) { int R, C; stage_rc(tid * 16 + i * 8192, R, C); const int Rb = Epi::PERM ? ((R & ~31) + perm32(R & 31)) : R;
        voffA[i] = (unsigned)(R * K + C) * 2u; voffB[i] = (unsigned)(Rb * K + C) * 2u; }
    const size_t kstep = (size_t)(BK * 2);
    const size_t hstep = (size_t)HALF * K * 2;
    const size_t tstep = 2 * hstep;
    const unsigned ldsw = (unsigned)wid * 1024u;
    const int aoff = lds_byte(wr * 64 + fr, fq * 8), boff = lds_byte(wc * 32 + fr, fq * 8);
#define PG8_SA(b, h) (((b) * 2 + (h)) * HTB)
#define PG8_SB(b, h) ((4 + (b) * 2 + (h)) * HTB)
#define PG8_STAGE(bufoff, gbase, voff) do { _Pragma("unroll") for (int _i = 0; _i < 2; ++_i) \
        __builtin_amdgcn_global_load_lds((const unsigned*)((const char*)(gbase) + (voff)[_i]), (PG8_LAS unsigned*)(lds + (bufoff) + ldsw + _i * 8192), 16, 0, 0); } while (0)
#define PG8_LDA(dst, b, h) do { _Pragma("unroll") for (int m = 0; m < 4; ++m) _Pragma("unroll") for (int k = 0; k < 2; ++k) dst[m][k] = *(const PG8_LAS bf16x8*)(lds + PG8_SA(b, h) + aoff + m * 2048 + k * 1024); } while (0)
#define PG8_LDB(dst, b, h) do { _Pragma("unroll") for (int n = 0; n < 2; ++n) _Pragma("unroll") for (int k = 0; k < 2; ++k) dst[n][k] = *(const PG8_LAS bf16x8*)(lds + PG8_SB(b, h) + boff + n * 2048 + k * 1024); } while (0)
#define PG8_MMA(ai, bj, At, Bt) do { __builtin_amdgcn_s_setprio(1); _Pragma("unroll") for (int m = 0; m < 4; ++m) _Pragma("unroll") for (int n = 0; n < 2; ++n) _Pragma("unroll") for (int k = 0; k < 2; ++k) \
        acc[ai][bj][m][n] = __builtin_amdgcn_mfma_f32_16x16x32_bf16(Bt[n][k], At[m][k], acc[ai][bj][m][n], 0, 0, 0); __builtin_amdgcn_s_setprio(0); } while (0)
#define PG8_WAIT_V(n) asm volatile("s_waitcnt vmcnt(" #n ")" ::: "memory")
#define PG8_WAIT_L(n) asm volatile("s_waitcnt lgkmcnt(" #n ")" ::: "memory")
#define PG8_BAR __builtin_amdgcn_s_barrier()
#define PG8_SCHED __builtin_amdgcn_sched_barrier(0)
    Unit cur, nxt; int ui = 0;
    if (!S.next(0, cur)) return;
    f32x4 acc[2][2][4][2];
#pragma unroll
    for (int a = 0; a < 2; ++a)
#pragma unroll
        for (int b = 0; b < 2; ++b)
#pragma unroll
            for (int m = 0; m < 4; ++m)
#pragma unroll
                for (int n = 0; n < 2; ++n) acc[a][b][m][n] = (f32x4){0.f, 0.f, 0.f, 0.f};
    bf16x8 At[4][2], B0[2][2], B1[2][2];
    const char* cA = (const char*)g.A + (size_t)cur.pm * tstep + (size_t)cur.k0 * 2; const char* cB = (const char*)g.Bt + (size_t)cur.pn * tstep + (size_t)cur.k0 * 2;
    S.a_ready(cur);
    if constexpr (SP2) {
        PG8_STAGE(PG8_SB(0, 0), cB, voffB); PG8_STAGE(PG8_SB(0, 1), cB + hstep, voffB); PG8_STAGE(PG8_SA(0, 0), cA, voffA); PG8_STAGE(PG8_SA(0, 1), cA + hstep, voffA);
        if (wr == 1) PG8_BAR;
        PG8_WAIT_V(2); PG8_BAR;
        PG8_STAGE(PG8_SB(1, 0), cB + kstep, voffB); PG8_STAGE(PG8_SA(1, 0), cA + kstep, voffA); PG8_STAGE(PG8_SB(1, 1), cB + hstep + kstep, voffB);
        PG8_WAIT_V(6); PG8_BAR;
    } else {
        PG8_STAGE(PG8_SB(0, 0), cB, voffB); PG8_STAGE(PG8_SA(0, 0), cA, voffA); PG8_STAGE(PG8_SB(0, 1), cB + hstep, voffB); PG8_STAGE(PG8_SA(0, 1), cA + hstep, voffA);
        if (wr == 1) PG8_BAR;
        PG8_WAIT_V(4); PG8_BAR;
        PG8_STAGE(PG8_SB(1, 0), cB + kstep, voffB); PG8_STAGE(PG8_SA(1, 0), cA + kstep, voffA); PG8_STAGE(PG8_SB(1, 1), cB + hstep + kstep, voffB);
        PG8_WAIT_V(6); PG8_BAR;
    }
    for (;;) {
        const bool has_next = S.next(ui + 1, nxt);
        const char* nA = has_next ? (const char*)g.A + (size_t)nxt.pm * tstep + (size_t)nxt.k0 * 2 : cA; const char* nB = has_next ? (const char*)g.Bt + (size_t)nxt.pn * tstep + (size_t)nxt.k0 * 2 : cB;
        const int nt = cur.nt;
        for (int t = 0; t < nt; t += 2) {
            const bool last = (t == nt - 2);
            const char* a1 = cA + (size_t)(t + 1) * kstep;
            const char* a2 = last ? nA : cA + (size_t)(t + 2) * kstep; const char* b2 = last ? nB : cB + (size_t)(t + 2) * kstep;
            const char* a3 = a2 + kstep; const char* b3 = b2 + kstep;
            if (last && has_next) S.a_ready(nxt);
            if constexpr (SP2) {
            PG8_LDB(B0, 0, 0); PG8_LDB(B1, 0, 1); PG8_SCHED; PG8_LDA(At, 0, 0); PG8_STAGE(PG8_SA(1, 1), a1 + hstep, voffA);
            PG8_WAIT_V(8); PG8_WAIT_L(0); PG8_BAR; PG8_MMA(0, 0, At, B0); PG8_MMA(0, 1, At, B1); PG8_BAR; PG8_SCHED;
            PG8_LDA(At, 0, 1); PG8_STAGE(PG8_SB(0, 0), b2, voffB); PG8_STAGE(PG8_SB(0, 1), b2 + hstep, voffB); PG8_STAGE(PG8_SA(0, 0), a2, voffA);
            PG8_WAIT_V(8); PG8_WAIT_L(0); PG8_BAR; PG8_MMA(1, 0, At, B0); PG8_MMA(1, 1, At, B1); PG8_BAR; PG8_SCHED;
            PG8_LDB(B0, 1, 0); PG8_LDB(B1, 1, 1); PG8_SCHED; PG8_LDA(At, 1, 0); PG8_STAGE(PG8_SA(0, 1), a2 + hstep, voffA);
            PG8_WAIT_V(8); PG8_WAIT_L(0); PG8_BAR; PG8_MMA(0, 0, At, B0); PG8_MMA(0, 1, At, B1); PG8_BAR; PG8_SCHED;
            PG8_LDA(At, 1, 1); PG8_STAGE(PG8_SB(1, 0), b3, voffB); PG8_STAGE(PG8_SB(1, 1), b3 + hstep, voffB); PG8_STAGE(PG8_SA(1, 0), a3, voffA);
            PG8_WAIT_V(8); PG8_WAIT_L(0); PG8_BAR; PG8_MMA(1, 0, At, B0); PG8_MMA(1, 1, At, B1); PG8_BAR; PG8_SCHED;
            } else {
            PG8_LDB(B0, 0, 0); PG8_SCHED; PG8_LDA(At, 0, 0); PG8_STAGE(PG8_SA(1, 1), a1 + hstep, voffA);
            PG8_WAIT_L(8); PG8_BAR; PG8_WAIT_L(0); PG8_MMA(0, 0, At, B0); PG8_BAR; PG8_SCHED;
            PG8_LDB(B1, 0, 1); PG8_STAGE(PG8_SB(0, 0), b2, voffB);
            PG8_BAR; PG8_WAIT_L(0); PG8_MMA(0, 1, At, B1); PG8_BAR;
            PG8_LDA(At, 0, 1); PG8_STAGE(PG8_SA(0, 0), a2, voffA);
            PG8_BAR; PG8_WAIT_L(0); PG8_MMA(1, 0, At, B0); PG8_BAR; PG8_SCHED;
            PG8_STAGE(PG8_SB(0, 1), b2 + hstep, voffB);
            PG8_WAIT_V(6); PG8_BAR; PG8_MMA(1, 1, At, B1); PG8_BAR;
            PG8_LDB(B0, 1, 0); PG8_SCHED; PG8_LDA(At, 1, 0); PG8_STAGE(PG8_SA(0, 1), a2 + hstep, voffA);
            PG8_WAIT_L(8); PG8_BAR; PG8_WAIT_L(0); PG8_MMA(0, 0, At, B0); PG8_BAR; PG8_SCHED;
            PG8_LDB(B1, 1, 1); PG8_STAGE(PG8_SB(1, 0), b3, voffB);
            PG8_BAR; PG8_WAIT_L(0); PG8_MMA(0, 1, At, B1); PG8_BAR;
            PG8_LDA(At, 1, 1); PG8_STAGE(PG8_SA(1, 0), a3, voffA);
            PG8_BAR; PG8_WAIT_L(0); PG8_MMA(1, 0, At, B0); PG8_BAR; PG8_SCHED;
            PG8_STAGE(PG8_SB(1, 1), b3 + hstep, voffB);
            PG8_WAIT_V(6); PG8_BAR; PG8_MMA(1, 1, At, B1); PG8_BAR;
            }
        }
        if constexpr (ALIGN_EPI) { if (wr == 0) PG8_BAR; }
        if constexpr (!Epi::AFTER_DRAIN) { E(acc, cur, wr, wc, fr, fq); S.done(cur); }
        if (!has_next) break;
#pragma unroll
        for (int a = 0; a < 2; ++a)
#pragma unroll
            for (int b = 0; b < 2; ++b)
#pragma unroll
                for (int m = 0; m < 4; ++m)
#pragma unroll
                    for (int n = 0; n < 2; ++n) acc[a][b][m][n] = (f32x4){0.f, 0.f, 0.f, 0.f};
        cur = nxt; cA = nA; cB = nB; ++ui;
        if constexpr (ALIGN_EPI) { if (wr == 1) PG8_BAR; }
    }
    PG8_WAIT_V(0);
    if constexpr (!ALIGN_EPI) { if (wr == 0) PG8_BAR; }
    PG8_BAR;
    if constexpr (Epi::AFTER_DRAIN) { E.fused(acc, cur, wr, wc, fr, fq, lds, wid, lane); S.done(cur); }
#undef PG8_SA
#undef PG8_SB
#undef PG8_STAGE
#undef PG8_LDA
#undef PG8_LDB
#undef PG8_MMA
#undef PG8_WAIT_V
#undef PG8_WAIT_L
#undef PG8_BAR
#undef PG8_SCHED
}
}
#define GAS __attribute__((address_space(1)))
#define LAS __attribute__((address_space(3)))
typedef unsigned short bf16;
typedef unsigned v4u __attribute__((ext_vector_type(4)));
typedef float f32x4 __attribute__((ext_vector_type(4)));
typedef short bf16x8 __attribute__((ext_vector_type(8)));
typedef GAS unsigned gu32;
typedef GAS unsigned long long gu64;
#define RLX_AGENT __ATOMIC_RELAXED, __HIP_MEMORY_SCOPE_AGENT
#define LDS_WAIT() asm volatile("s_waitcnt lgkmcnt(0)" ::: "memory")
#define VM_WAIT() asm volatile("s_waitcnt vmcnt(0)" ::: "memory")
__device__ __forceinline__ unsigned long long rt() { return __builtin_amdgcn_s_memrealtime(); }
__device__ __forceinline__ unsigned f2bf(float f) { unsigned u = __builtin_bit_cast(unsigned, f); return (u + 0x7fffu + ((u >> 16) & 1u)) >> 16; }
__device__ __forceinline__ unsigned pk2(float lo, float hi) { return f2bf(lo) | (f2bf(hi) << 16); }

#define XB_TMO      128
#define XB_XCNT(j)  (256  + 64 * (j))
#define XB_XSUB(j)  (1280 + 64 * (j))
#define XB_XGEN(j)  (2304 + 64 * (j))
#define XB_TOP      3328
#define XB_TOPGEN   3392
#define XCD_BAR_WORDS 3456
#define XB_SPIN_CAP (1u << 18)

__device__ __forceinline__ unsigned xb_ld(unsigned* p)              { return __hip_atomic_load(p, __ATOMIC_RELAXED, __HIP_MEMORY_SCOPE_AGENT); }
__device__ __forceinline__ unsigned xb_add(unsigned* p, unsigned v) { return __hip_atomic_fetch_add(p, v, __ATOMIC_RELAXED, __HIP_MEMORY_SCOPE_AGENT); }
__device__ __forceinline__ unsigned xb_xcc_id() { return (unsigned)__builtin_amdgcn_s_getreg((3 << 11) | 20) & 0xFu; }
#define XB_SPIN(cond, bar) do { unsigned _sp = 0; while (cond) { __builtin_amdgcn_s_sleep(1); \
    if ((++_sp & 255u) == 0u) { if (xb_ld(&(bar)[XB_TMO])) break; if (_sp > XB_SPIN_CAP) { atomicAdd(&(bar)[XB_TMO], 1u); break; } } } } while (0)

struct XcdBarrier {
    unsigned* bar; unsigned x;
    volatile LAS unsigned* st;
};

__device__ __forceinline__ XcdBarrier xcd_barrier_post(unsigned* bar, volatile LAS unsigned* st) {
    XcdBarrier b; b.bar = bar; b.x = xb_xcc_id(); b.st = st;
    if (threadIdx.x == 0) (void)xb_add(&bar[XB_XCNT(b.x)], 1u);
    return b;
}
__device__ __forceinline__ void xcd_barrier_complete(unsigned* bar, unsigned x, unsigned& nloc, unsigned& nx) {
    const unsigned G = gridDim.x * gridDim.y * gridDim.z;
    unsigned sum, cnt, mine, sp = 0u;
    for (;;) {
        sum = 0u; cnt = 0u; mine = 0u;
#pragma unroll
        for (unsigned j = 0; j < 16; ++j) { const unsigned c = xb_ld(&bar[XB_XCNT(j)]); sum += c; cnt += (c > 0u) ? 1u : 0u; mine = (j == x) ? c : mine; }
        if (sum == G) break;
        __builtin_amdgcn_s_sleep(1);
        if ((++sp & 255u) == 0u) { if (xb_ld(&bar[XB_TMO])) break; if (sp > XB_SPIN_CAP) { atomicAdd(&bar[XB_TMO], 1u); break; } }
    }
    nloc = mine > 0u ? mine : 1u; nx = cnt > 0u ? cnt : 1u;
}

__device__ __forceinline__ void xcd_barrier(const XcdBarrier& b) {
    asm volatile("s_waitcnt vmcnt(0)" ::: "memory");
    __syncthreads();
    if (threadIdx.x == 0) {
        unsigned* bar = b.bar;
        __builtin_amdgcn_s_waitcnt(0);
        unsigned nloc = b.st[0], nx = b.st[1];
        if (nloc == 0u) { xcd_barrier_complete(bar, b.x, nloc, nx); b.st[0] = nloc; b.st[1] = nx; }
        const unsigned old = xb_add(&bar[XB_XSUB(b.x)], 1u);
        const unsigned gen = old / nloc;
        if (old + 1u == (gen + 1u) * nloc) {
            __builtin_amdgcn_fence(__ATOMIC_RELEASE, "agent");
            asm volatile("s_waitcnt vmcnt(0)" ::: "memory");
            const unsigned og = xb_add(&bar[XB_TOP], 1u);
            const unsigned tg = og / nx;
            if (og + 1u == (tg + 1u) * nx) xb_add(&bar[XB_TOPGEN], 1u);
            else XB_SPIN(xb_ld(&bar[XB_TOPGEN]) == tg, bar);
            __builtin_amdgcn_fence(__ATOMIC_ACQUIRE, "agent");
            xb_add(&bar[XB_XGEN(b.x)], 1u);
            asm volatile("s_waitcnt vmcnt(0)" ::: "memory");
        } else {
            XB_SPIN(xb_ld(&bar[XB_XGEN(b.x)]) == gen, bar);
            __builtin_amdgcn_fence(__ATOMIC_ACQUIRE, "agent");
            asm volatile("s_waitcnt vmcnt(0)" ::: "memory");
        }
    }
    __syncthreads();
}
constexpr int NWAVES = 8;
constexpr int D = 2048, FF = 5632, NP = 8192, NS = 1024, M = NP + NS, NHEAD = 16, HD = 128, NREL = 513, BAND = 576;
constexpr float LN_EPS = 1e-5f, ALPHA = 1.4142135623730951f  ;
constexpr size_t MiB = 1u << 20;
constexpr size_t WS_CTL = 0, CTL_ZERO_BYTES = 64 * 1024;
constexpr size_t WS_WIN = 2 * MiB, WS_WOUT = 26 * MiB, WS_WKVQ = 34 * MiB, WS_WO = 58 * MiB, WS_WGU0 = 66 * MiB, WS_WGU1 = 110 * MiB, WS_WD0 = 154 * MiB, WS_WD1 = 176 * MiB;
constexpr size_t WS_XB = 198 * MiB, WS_PRE = 234 * MiB, WS_X = 306 * MiB, WS_KS = 378 * MiB, WS_VS = 414 * MiB, WS_UNI = 450 * MiB, WS_PART = 594 * MiB, WS_END = 618 * MiB;
constexpr size_t WS_BB = WS_UNI, WS_UB = WS_UNI + 36 * MiB, WS_A2 = WS_UNI + 72 * MiB;
constexpr size_t WS_KP = WS_UNI, WS_VP = WS_UNI + 36 * MiB, WS_QB = WS_UNI + 72 * MiB, WS_ATT = WS_UNI + 108 * MiB;
constexpr size_t WS_H = WS_UNI;
constexpr int CW_BAR = 1024;
constexpr int RING_OFF = 0, RING_BYTES = 131072, LDSCTL_OFF = 135168, MISC_OFF = LDSCTL_OFF + 320, LDS_BYTES = 147456;


struct Frame {
    LAS unsigned char* lds; volatile LAS unsigned* MISC; gu32* ctl;
    int tid, lane, wave, vcu, G;
};

__device__ __forceinline__ float wave_sum(float v) {
#pragma unroll
    for (int o = 1; o < 64; o <<= 1) v += __shfl_xor(v, o);
    return v;
}

__device__ __forceinline__ int dest_row(int mode, int row_off, int n) {
    if (mode == 1) { if (n < 2048) return n; if (n < 4096) { const int j = n - 2048; return 2048 + 256 * (j >> 7) + (j & 127); } const int j = n - 4096; return 2048 + 256 * (j >> 7) + 128 + (j & 127); }
    if (mode == 2) { if (n < 5632) return 256 * (n >> 7) + (n & 127); const int j = n - 5632; return 256 * (j >> 7) + 128 + (j & 127); }
    return row_off + n;
}
__device__ __forceinline__ void p0_transpose_item(const float* W, int K, int N, bf16* WT, int mode, int row_off, LAS float* scr, int item, int lane) {
    const int nblk = N >> 6, kb = item / nblk, nb = item - kb * nblk, k0 = 64 * kb, n0 = 64 * nb;
    const int lr = lane >> 4, lc = (lane & 15) * 4;
#pragma unroll 4
    for (int i = 0; i < 16; ++i) { const int kk = 4 * i + lr; const f32x4 v = *(const GAS f32x4*)(W + (size_t)(k0 + kk) * N + n0 + lc);
        LAS float* s = scr + kk * 65 + lc; s[0] = v.x; s[1] = v.y; s[2] = v.z; s[3] = v.w; }
    LDS_WAIT(); asm volatile("" ::: "memory");
    const int c = lane & 7, d0 = dest_row(mode, row_off, n0);
#pragma unroll
    for (int j = 0; j < 8; ++j) { const int n = (lane >> 3) + 8 * j; const LAS float* s = scr + (8 * c) * 65 + n;
        v4u o; o.x = pk2(s[0 * 65], s[1 * 65]); o.y = pk2(s[2 * 65], s[3 * 65]); o.z = pk2(s[4 * 65], s[5 * 65]); o.w = pk2(s[6 * 65], s[7 * 65]);
        *(GAS v4u*)(WT + (size_t)(d0 + n) * K + k0 + 8 * c) = o; }
    LDS_WAIT(); asm volatile("" ::: "memory");
}
__device__ __forceinline__ void cvt_rows(const float* src, bf16* dst, int nrows, int srows, int drows, int doff, int gt, int NGT) {
    for (int i = gt; i < nrows * 256; i += NGT) { const int r = i >> 8, c = (i & 255) * 8;
        const f32x4 a = *(const GAS f32x4*)(src + (size_t)r * D + c), b = *(const GAS f32x4*)(src + (size_t)r * D + c + 4);
        v4u o; o.x = pk2(a.x, a.y); o.y = pk2(a.z, a.w); o.z = pk2(b.x, b.y); o.w = pk2(b.z, b.w);
        const int dr = (r / srows) * drows + doff + (r % srows);
        *(GAS v4u*)(dst + (size_t)dr * D + c) = o; }
}
struct Ptrs {
    const float *x_prompt, *x_sample, *state_conv, *cache_k, *cache_v, *w_in_a, *conv_w, *w_out_a, *w_kv, *w_q, *w_o, *rel_bias, *ln_g, *ln_b, *w_gate_up, *w_down;
    float* out; unsigned char* ws;
};
constexpr int I_IN = (D / 64) * (3 * D / 64), I_SQ = (D / 64) * (D / 64), I_KV = (D / 64) * (2 * D / 64), I_GU = (D / 64) * (2 * FF / 64), I_DN = (FF / 64) * (D / 64);
constexpr int IT0 = 0, IT1 = I_IN, IT2 = IT1 + I_SQ + I_GU, IT3 = IT2 + I_DN + I_KV + I_SQ, IT4 = IT3 + I_SQ, IT5 = IT4 + I_GU, IT6 = IT5 + I_DN;
__device__ __forceinline__ void convert_items(Frame& F, const Ptrs& P, int first, int last, int worker, int nworkers) {
    LAS float* scr = (LAS float*)(F.lds + RING_OFF) + F.wave * (64 * 65);
    unsigned char* ws = P.ws;
    for (int it = first + worker * NWAVES + F.wave; it < last; it += nworkers * NWAVES) {
        int r = it;
        if (r < I_IN) { p0_transpose_item(P.w_in_a, D, 3 * D, (bf16*)(ws + WS_WIN), 1, 0, scr, r, F.lane); continue; } r -= I_IN;
        if (r < I_SQ) { p0_transpose_item(P.w_out_a, D, D, (bf16*)(ws + WS_WOUT), 0, 0, scr, r, F.lane); continue; } r -= I_SQ;
        if (r < I_GU) { p0_transpose_item(P.w_gate_up, D, 2 * FF, (bf16*)(ws + WS_WGU0), 2, 0, scr, r, F.lane); continue; } r -= I_GU;
        if (r < I_DN) { p0_transpose_item(P.w_down, FF, D, (bf16*)(ws + WS_WD0), 0, 0, scr, r, F.lane); continue; } r -= I_DN;
        if (r < I_KV) { p0_transpose_item(P.w_kv, D, 2 * D, (bf16*)(ws + WS_WKVQ), 0, 0, scr, r, F.lane); continue; } r -= I_KV;
        if (r < I_SQ) { p0_transpose_item(P.w_q, D, D, (bf16*)(ws + WS_WKVQ), 0, 2 * D, scr, r, F.lane); continue; } r -= I_SQ;
        if (r < I_SQ) { p0_transpose_item(P.w_o, D, D, (bf16*)(ws + WS_WO), 0, 0, scr, r, F.lane); continue; } r -= I_SQ;
        if (r < I_GU) { p0_transpose_item(P.w_gate_up + (size_t)D * 2 * FF, D, 2 * FF, (bf16*)(ws + WS_WGU1), 2, 0, scr, r, F.lane); continue; } r -= I_GU;
        p0_transpose_item(P.w_down + (size_t)FF * D, FF, D, (bf16*)(ws + WS_WD1), 0, 0, scr, r, F.lane);
    }
}
__device__ __forceinline__ void filler_static(Frame& F, const Ptrs& P, int nwg, int first, int last) {
    const int rem = nwg % F.G, c = (int)blockIdx.x;
    if (rem == 0) convert_items(F, P, first, last, c, F.G); else if (c >= rem) convert_items(F, P, first, last, c - rem, F.G - rem);
}
__device__ __forceinline__ void filler_tail(Frame& F, const Ptrs& P, int first, int last) {
    if (F.G == 256) { if (F.vcu & 1) convert_items(F, P, first, last, F.vcu >> 1, 128); } else convert_items(F, P, first, last, F.vcu, F.G);
}
__device__ __forceinline__ void p0_prologue(Frame& F, const Ptrs& P) {
    unsigned char* ws = P.ws;
    convert_items(F, P, IT0, IT1, F.vcu, F.G);
    const int gt = (F.vcu * NWAVES + F.wave) * 64 + F.lane, NGT = F.G * NWAVES * 64;
    cvt_rows(P.x_prompt, (bf16*)(ws + WS_XB), NP, NP, NP, 0, gt, NGT);
    cvt_rows(P.x_sample, (bf16*)(ws + WS_XB) + (size_t)NP * D, NS, NS, NS, 0, gt, NGT);
    cvt_rows(P.cache_k, (bf16*)(ws + WS_KS), 16 * 512, 512, BAND, 0, gt, NGT);
    cvt_rows(P.cache_v, (bf16*)(ws + WS_VS), 16 * 512, 512, BAND, 0, gt, NGT);
}

__device__ __forceinline__ void unpack8(const v4u w, float (&f)[8]) {
#pragma unroll
    for (int i = 0; i < 4; ++i) { f[2 * i] = __builtin_bit_cast(float, w[i] << 16); f[2 * i + 1] = __builtin_bit_cast(float, w[i] & 0xffff0000u); }
}
__device__ __forceinline__ void conv_phase(Frame& F, const Ptrs& P) {
    const bf16* Bb = (const bf16*)(P.ws + WS_BB); const bf16* Ub = (const bf16*)(P.ws + WS_UB); bf16* A2 = (bf16*)(P.ws + WS_A2);
    const int gt = (F.vcu * NWAVES + F.wave) * 64 + F.lane, NGT = F.G * NWAVES * 64;
    for (int i = gt; i < M * 256; i += NGT) { const int row = i >> 8, c = (i & 255) * 8;
        const int t = row < NP ? row : (row & 63);
        float b[8], u2[8], u1[8], u0[8], w0[8], w1[8], w2[8];
        unpack8(*(const GAS v4u*)(Bb + (size_t)row * D + c), b); unpack8(*(const GAS v4u*)(Ub + (size_t)row * D + c), u2);
        const float* hist = (row < NP) ? nullptr : P.state_conv + (size_t)((row - NP) >> 6) * 2 * D + c;
        if (t >= 1) unpack8(*(const GAS v4u*)(Ub + (size_t)(row - 1) * D + c), u1);
        else { if (hist) { const f32x4 a = *(const GAS f32x4*)(hist + D), bb = *(const GAS f32x4*)(hist + D + 4); u1[0] = a.x; u1[1] = a.y; u1[2] = a.z; u1[3] = a.w; u1[4] = bb.x; u1[5] = bb.y; u1[6] = bb.z; u1[7] = bb.w; }
               else {
#pragma unroll
                   for (int e = 0; e < 8; ++e) u1[e] = 0.f; } }
        if (t >= 2) unpack8(*(const GAS v4u*)(Ub + (size_t)(row - 2) * D + c), u0);
        else { if (hist) { const float* hp = hist + t * D; const f32x4 a = *(const GAS f32x4*)(hp), bb = *(const GAS f32x4*)(hp + 4); u0[0] = a.x; u0[1] = a.y; u0[2] = a.z; u0[3] = a.w; u0[4] = bb.x; u0[5] = bb.y; u0[6] = bb.z; u0[7] = bb.w; }
               else {
#pragma unroll
                   for (int e = 0; e < 8; ++e) u0[e] = 0.f; } }
        { const f32x4 a = *(const GAS f32x4*)(P.conv_w + c), bb = *(const GAS f32x4*)(P.conv_w + c + 4); w0[0] = a.x; w0[1] = a.y; w0[2] = a.z; w0[3] = a.w; w0[4] = bb.x; w0[5] = bb.y; w0[6] = bb.z; w0[7] = bb.w; }
        { const f32x4 a = *(const GAS f32x4*)(P.conv_w + D + c), bb = *(const GAS f32x4*)(P.conv_w + D + c + 4); w1[0] = a.x; w1[1] = a.y; w1[2] = a.z; w1[3] = a.w; w1[4] = bb.x; w1[5] = bb.y; w1[6] = bb.z; w1[7] = bb.w; }
        { const f32x4 a = *(const GAS f32x4*)(P.conv_w + 2 * D + c), bb = *(const GAS f32x4*)(P.conv_w + 2 * D + c + 4); w2[0] = a.x; w2[1] = a.y; w2[2] = a.z; w2[3] = a.w; w2[4] = bb.x; w2[5] = bb.y; w2[6] = bb.z; w2[7] = bb.w; }
        float r[8];
#pragma unroll
        for (int e = 0; e < 8; ++e) r[e] = b[e] * (w0[e] * u0[e] + w1[e] * u1[e] + w2[e] * u2[e]);
        v4u o; o.x = pk2(r[0], r[1]); o.y = pk2(r[2], r[3]); o.z = pk2(r[4], r[5]); o.w = pk2(r[6], r[7]);
        *(GAS v4u*)(A2 + (size_t)row * D + c) = o; }
}

__device__ __forceinline__ void ln_phase(Frame& F, const float* PRE, const float* PART, const float* g, const float* b, float* Xout, bf16* XBout) {
    const int gw = F.vcu * NWAVES + F.wave, NGW = F.G * NWAVES;
    for (int row = gw; row < M; row += NGW) {
        const GAS f32x4* xr = (const GAS f32x4*)(PRE + (size_t)row * D) + F.lane;
        f32x4 v[8]; float s = 0.f;
#pragma unroll
        for (int j = 0; j < 8; ++j) v[j] = xr[64 * j];
        if (PART && row >= NP) {
#pragma unroll
            for (int q = 0; q < 3; ++q) { const GAS f32x4* pr = (const GAS f32x4*)(PART + ((size_t)q * NS + (row - NP)) * D) + F.lane;
#pragma unroll
                for (int j = 0; j < 8; ++j) v[j] = v[j] + pr[64 * j]; } }
#pragma unroll
        for (int j = 0; j < 8; ++j) s += (v[j].x + v[j].y) + (v[j].z + v[j].w);
        const float mean = wave_sum(s) * (1.f / D); float s2 = 0.f;
#pragma unroll
        for (int j = 0; j < 8; ++j) { v[j] = v[j] - mean; s2 += (v[j].x * v[j].x + v[j].y * v[j].y) + (v[j].z * v[j].z + v[j].w * v[j].w); }
        const float rstd = 1.f / sqrtf(wave_sum(s2) * (1.f / D) + LN_EPS);
        GAS f32x4* o4 = (GAS f32x4*)(Xout + (size_t)row * D) + F.lane;
        const GAS f32x4* g4 = (const GAS f32x4*)g + F.lane; const GAS f32x4* b4 = (const GAS f32x4*)b + F.lane;
#pragma unroll
        for (int j = 0; j < 8; ++j) { const f32x4 y = v[j] * rstd * g4[64 * j] + b4[64 * j]; if (Xout) o4[64 * j] = y;
            if (XBout) { GAS unsigned long long* o8 = (GAS unsigned long long*)(XBout + (size_t)row * D) + F.lane; o8[64 * j] = (unsigned long long)pk2(y.x, y.y) | ((unsigned long long)pk2(y.z, y.w) << 32); } }
    }
}

namespace att {
typedef short s16x4 __attribute__((ext_vector_type(4)));
constexpr int PITCH = 272, HEADB = 64 * PITCH, KOFF = 0, VOFF = 2 * HEADB, BOFF = 4 * HEADB, TBN = 520;
static_assert(BOFF + 2 * TBN * 4 <= RING_BYTES, "attention LDS");
__device__ __forceinline__ s16x4 vtr(const LAS unsigned char* p) { return __builtin_bit_cast(s16x4, __builtin_amdgcn_ds_read_tr16_b64_v4i16((LAS s16x4*)p)); }
__device__ __forceinline__ void attn_phase(Frame& F, const Ptrs& P) {
    const bf16* Qb = (const bf16*)(P.ws + WS_QB); const bf16* Kp = (const bf16*)(P.ws + WS_KP); const bf16* Vp = (const bf16*)(P.ws + WS_VP);
    const bf16* KS = (const bf16*)(P.ws + WS_KS); const bf16* VS = (const bf16*)(P.ws + WS_VS); bf16* ATT = (bf16*)(P.ws + WS_ATT);
    LAS unsigned char* lds = F.lds + RING_OFF;
    const int tid = F.tid, lane = F.lane, wid = F.wave, fr = lane & 15, fq = lane >> 4;
    const int hl = wid >> 2, qs = (wid & 3) * 16, qi = qs + fr;
    LAS float* tb = (LAS float*)(lds + BOFF);
    const float C = 0.08838834764831845f * 1.4426950408889634f;
    for (int unit = F.vcu; unit < 144 * 8; unit += F.G) {
        const int hp = unit & 7, cidx = unit >> 3, hh = hp * 2 + hl;
        int qrow0, t0, krow_base; const bf16 *Kb, *Vb;
        if (cidx < 128) { qrow0 = 64 * cidx; t0 = cidx < 8 ? 8 - cidx : 0; Kb = Kp; Vb = Vp; krow_base = 64 * (cidx - 8); }
        else { const int n = cidx - 128; qrow0 = NP + 64 * n; t0 = 0; Kb = KS; Vb = VS; krow_base = BAND * n; }
        __syncthreads();
        for (int i = tid; i < 2 * NREL; i += NWAVES * 64) { const int h2 = i >= NREL ? 1 : 0, r = i - h2 * NREL; tb[h2 * TBN + r] = P.rel_bias[(size_t)(hp * 2 + h2) * NREL + r] * 1.4426950408889634f; }
        bf16x8 qf[4];
        { const bf16* qp = Qb + (size_t)(qrow0 + qi) * D + hh * HD + fq * 8;
#pragma unroll
          for (int s = 0; s < 4; ++s) qf[s] = *(const GAS bf16x8*)(qp + s * 32); }
        v4u kreg[4], vreg[4];
        const int lkey = tid >> 5, lch = tid & 31;
        const unsigned ldst = (unsigned)((lch >> 4) * HEADB + lkey * PITCH + (lch & 15) * 16);
#define AT_LOAD(t) do { const size_t ro_ = (size_t)(krow_base + 64 * (t) + lkey) * D + hp * 256 + lch * 8; \
        _Pragma("unroll") for (int p_ = 0; p_ < 4; ++p_) { kreg[p_] = *(const GAS v4u*)(Kb + ro_ + (size_t)p_ * 16 * D); vreg[p_] = *(const GAS v4u*)(Vb + ro_ + (size_t)p_ * 16 * D); } } while (0)
        AT_LOAD(t0);
        float mrun = -INFINITY, lrun = 0.f; f32x4 o[8];
#pragma unroll
        for (int dt = 0; dt < 8; ++dt) o[dt] = (f32x4){0.f, 0.f, 0.f, 0.f};
        const LAS unsigned char* kfb = lds + KOFF + hl * HEADB + fr * PITCH + fq * 16;
        const LAS unsigned char* vfb = lds + VOFF + hl * HEADB + (4 * fq + (fr >> 2)) * PITCH + (fr & 3) * 8;
        for (int t = t0; t < 9; ++t) {
            __syncthreads();
#pragma unroll
            for (int p = 0; p < 4; ++p) { *(LAS v4u*)(lds + KOFF + ldst + p * 16 * PITCH) = kreg[p]; *(LAS v4u*)(lds + VOFF + ldst + p * 16 * PITCH) = vreg[p]; }
            __syncthreads();
            if (t + 1 < 9) AT_LOAD(t + 1);
            f32x4 sc[4];
#pragma unroll
            for (int s = 0; s < 4; ++s) { f32x4 a = (f32x4){0.f, 0.f, 0.f, 0.f};
#pragma unroll
                for (int st = 0; st < 4; ++st) { const bf16x8 kf = *(const LAS bf16x8*)(kfb + s * 16 * PITCH + st * 64); a = __builtin_amdgcn_mfma_f32_16x16x32_bf16(kf, qf[st], a, 0, 0, 0); }
                sc[s] = a; }
            float tmax = -INFINITY;
#pragma unroll
            for (int s = 0; s < 4; ++s)
#pragma unroll
                for (int r = 0; r < 4; ++r) { const int jb = 64 * t + 16 * s + 4 * fq + r; int rel = 512 + qi - jb; rel = rel > 256 ? 256 : (rel < -256 ? -256 : rel);
                    const float v = sc[s][r] * C + tb[hl * TBN + rel + 256]; sc[s][r] = v; tmax = fmaxf(tmax, v); }
            tmax = fmaxf(tmax, __shfl_xor(tmax, 16)); tmax = fmaxf(tmax, __shfl_xor(tmax, 32));
            const float mnew = fmaxf(mrun, tmax), alpha = __builtin_amdgcn_exp2f(mrun - mnew); mrun = mnew;
            float psum = 0.f;
#pragma unroll
            for (int s = 0; s < 4; ++s)
#pragma unroll
                for (int r = 0; r < 4; ++r) { const float p = __builtin_amdgcn_exp2f(sc[s][r] - mnew); sc[s][r] = p; psum += p; }
            lrun = lrun * alpha + psum;
#pragma unroll
            for (int dt = 0; dt < 8; ++dt) o[dt] = o[dt] * alpha;
            bf16x8 pb[2];
#pragma unroll
            for (int ks = 0; ks < 2; ++ks) { const v4u w = {pk2(sc[2 * ks][0], sc[2 * ks][1]), pk2(sc[2 * ks][2], sc[2 * ks][3]), pk2(sc[2 * ks + 1][0], sc[2 * ks + 1][1]), pk2(sc[2 * ks + 1][2], sc[2 * ks + 1][3])}; pb[ks] = __builtin_bit_cast(bf16x8, w); }
#pragma unroll
            for (int dt = 0; dt < 8; ++dt)
#pragma unroll
                for (int ks = 0; ks < 2; ++ks) { const s16x4 va = vtr(vfb + (32 * ks) * PITCH + dt * 32), vb = vtr(vfb + (32 * ks + 16) * PITCH + dt * 32);
                    const bf16x8 vf = {va[0], va[1], va[2], va[3], vb[0], vb[1], vb[2], vb[3]};
                    o[dt] = __builtin_amdgcn_mfma_f32_16x16x32_bf16(vf, pb[ks], o[dt], 0, 0, 0); }
        }
#undef AT_LOAD
        lrun += __shfl_xor(lrun, 16); lrun += __shfl_xor(lrun, 32);
        const float inv = 1.0f / lrun;
        bf16* op = ATT + (size_t)(qrow0 + qi) * D + hh * HD + 4 * fq;
#pragma unroll
        for (int dt = 0; dt < 8; ++dt) { const f32x4 y = o[dt] * inv; *(GAS unsigned long long*)(op + dt * 16) = (unsigned long long)pk2(y.x, y.y) | ((unsigned long long)pk2(y.z, y.w) << 32); }
    }
    __syncthreads();
}
}

#ifndef MK_ONE_LAUNCH
#define MK_ONE_LAUNCH 1
#endif
#ifndef MK_REP_MASK
#define MK_REP_MASK 0
#endif
#define REP(k) for (int rep_ = 0; rep_ <= ((MK_REP_MASK >> (k)) & 1); ++rep_)
constexpr int N_PHASES = 15;
struct Args { Ptrs p; int ph_lo, ph_hi; };
__global__ void __launch_bounds__(NWAVES * 64, 2) yoco_fwd(Args args) {
    extern __shared__ __attribute__((aligned(16))) unsigned char lds_raw[];
    Frame F;
    F.lds = (LAS unsigned char*)lds_raw;
    F.MISC = (volatile LAS unsigned*)(F.lds + MISC_OFF);
    F.tid = threadIdx.x; F.lane = F.tid & 63; F.wave = __builtin_amdgcn_readfirstlane(F.tid >> 6);
    F.G = gridDim.x; { const int bx = blockIdx.x; F.vcu = (F.G % 8 == 0) ? (bx % 8) * (F.G / 8) + bx / 8 : bx; }
    const Ptrs& P = args.p;
    unsigned char* ws = P.ws;
    F.ctl = (gu32*)(ws + WS_CTL);
    for (int u = F.tid; u < (LDS_BYTES - LDSCTL_OFF) / 4; u += NWAVES * 64) ((LAS unsigned*)(F.lds + LDSCTL_OFF))[u] = 0u;
    __syncthreads();
#if MK_ONE_LAUNCH
    XcdBarrier bar = xcd_barrier_post((unsigned*)(F.ctl + CW_BAR), F.MISC + 8);
#define GRID_BAR() xcd_barrier(bar)
#else
#define GRID_BAR() do {} while (0)
#endif
    const int lo = args.ph_lo, hi = args.ph_hi;
#define IN(k) (lo <= (k) && (k) < hi)
#define SEAM(k) do { if (IN(k) && IN((k) + 1)) GRID_BAR(); } while (0)
    bf16* XB = (bf16*)(ws + WS_XB); float* PRE = (float*)(ws + WS_PRE); float* X = (float*)(ws + WS_X); bf16* HB = (bf16*)(ws + WS_H);
    float* PART = (float*)(ws + WS_PART);
    float* out = P.out;
    float* y_out = out;
    float* conv_p = out + (size_t)M * D;
    float* conv_s = conv_p + 2 * D;
    float* k_prompt = conv_s + 32 * D;
    float* v_prompt = k_prompt + (size_t)512 * D;
    float* k_sample = v_prompt + (size_t)512 * D;
    float* v_sample = k_sample + (size_t)NS * D;

    if (IN(0)) {
        REP(0) p0_prologue(F, P);
#if MK_ONE_LAUNCH
        if (IN(1)) GRID_BAR();
#endif
    }
    if (IN(1)) {
        pg8::Gemm g{XB, (const bf16*)(ws + WS_WIN), M, 3 * D, D}; pg8::StaticOrder S; S.init(M, 3 * D, D, F.G, (int)blockIdx.x);
        pg8::EpiInA E{(bf16*)(ws + WS_BB), (bf16*)(ws + WS_UB), conv_p, conv_s};
        pg8::gemm_phase<pg8::EpiInA, pg8::StaticOrder, true, true>(F.lds + RING_OFF, g, S, E);
        filler_static(F, P, (M / 256) * (3 * D / 256), IT1, IT2);
        SEAM(1);
    }
    if (IN(2)) { REP(2) conv_phase(F, P); SEAM(2); }
    if (IN(3)) {
        pg8::Gemm g{(const bf16*)(ws + WS_A2), (const bf16*)(ws + WS_WOUT), M, D, D}; pg8::TailSplitOrder S; S.init(D, F.G, F.vcu);
        pg8::EpiResid E{P.x_prompt, P.x_sample, nullptr, PRE, ALPHA, PART};
        pg8::gemm_phase<pg8::EpiResid, pg8::TailSplitOrder, true, true>(F.lds + RING_OFF, g, S, E);
        SEAM(3);
    }
    if (IN(4)) { REP(4) ln_phase(F, PRE, PART, P.ln_g + 0 * D, P.ln_b + 0 * D, nullptr, XB); SEAM(4); }
    if (IN(5)) {
        pg8::Gemm g{XB, (const bf16*)(ws + WS_WGU0), M, 2 * FF, D}; pg8::StaticOrder S; S.init(M, 2 * FF, D, F.G, (int)blockIdx.x);
        pg8::EpiSwiGLU E{HB};
        pg8::gemm_phase<pg8::EpiSwiGLU, pg8::StaticOrder, true, true>(F.lds + RING_OFF, g, S, E);
        filler_static(F, P, (M / 256) * (2 * FF / 256), IT2, IT3);
        SEAM(5);
    }
    if (IN(6)) {
        pg8::Gemm g{HB, (const bf16*)(ws + WS_WD0), M, D, FF}; pg8::TailSplitOrder S; S.init(FF, F.G, F.vcu);
        pg8::EpiResid E{nullptr, nullptr, XB, PRE, ALPHA, PART};
        pg8::gemm_phase<pg8::EpiResid, pg8::TailSplitOrder, true, true>(F.lds + RING_OFF, g, S, E);
        filler_tail(F, P, IT3, IT4);
        SEAM(6);
    }
    if (IN(7)) { REP(7) ln_phase(F, PRE, PART, P.ln_g + 1 * D, P.ln_b + 1 * D, nullptr, XB); SEAM(7); }
    if (IN(8)) {
        pg8::Gemm g{XB, (const bf16*)(ws + WS_WKVQ), M, 3 * D, D}; pg8::StaticOrder S; S.init(M, 3 * D, D, F.G, (int)blockIdx.x);
        pg8::EpiKVQ E{(bf16*)(ws + WS_KP), (bf16*)(ws + WS_VP), (bf16*)(ws + WS_KS), (bf16*)(ws + WS_VS), (bf16*)(ws + WS_QB), k_prompt, v_prompt, k_sample, v_sample};
        pg8::gemm_phase<pg8::EpiKVQ, pg8::StaticOrder, true, true>(F.lds + RING_OFF, g, S, E);
        filler_static(F, P, (M / 256) * (3 * D / 256), IT4, IT5);
        SEAM(8);
    }
    if (IN(9)) { REP(9) att::attn_phase(F, P); SEAM(9); }
    if (IN(10)) {
        pg8::Gemm g{(const bf16*)(ws + WS_ATT), (const bf16*)(ws + WS_WO), M, D, D}; pg8::TailSplitOrder S; S.init(D, F.G, F.vcu);
        pg8::EpiResid E{nullptr, nullptr, XB, PRE, ALPHA, PART};
        pg8::gemm_phase<pg8::EpiResid, pg8::TailSplitOrder, true, true>(F.lds + RING_OFF, g, S, E);
        SEAM(10);
    }
    if (IN(11)) { REP(11) ln_phase(F, PRE, PART, P.ln_g + 2 * D, P.ln_b + 2 * D, nullptr, XB); SEAM(11); }
    if (IN(12)) {
        pg8::Gemm g{XB, (const bf16*)(ws + WS_WGU1), M, 2 * FF, D}; pg8::StaticOrder S; S.init(M, 2 * FF, D, F.G, (int)blockIdx.x);
        pg8::EpiSwiGLU E{HB};
        pg8::gemm_phase<pg8::EpiSwiGLU, pg8::StaticOrder, true, true>(F.lds + RING_OFF, g, S, E);
        filler_static(F, P, (M / 256) * (2 * FF / 256), IT5, IT6);
        SEAM(12);
    }
    if (IN(13)) {
        pg8::Gemm g{HB, (const bf16*)(ws + WS_WD1), M, D, FF}; pg8::TailSplitOrder S; S.init(FF, F.G, F.vcu);
        pg8::EpiResid E{nullptr, nullptr, XB, PRE, ALPHA, PART};
        pg8::gemm_phase<pg8::EpiResid, pg8::TailSplitOrder, true, true>(F.lds + RING_OFF, g, S, E);
        SEAM(13);
    }
    if (IN(14)) { REP(14) ln_phase(F, PRE, PART, P.ln_g + 3 * D, P.ln_b + 3 * D, y_out, nullptr); }
#undef IN
#undef SEAM
}

extern "C" void kernel_launch(void* const* d_in, const int* in_sizes, int n_in, void* d_out, int out_size, void* d_ws, size_t ws_size, hipStream_t stream) {
    static int grid = 0;
    if (grid == 0) {
        if (n_in != 16 || ws_size < WS_END) { fprintf(stderr, "kernel_launch: unexpected n_in %d / ws_size %zu (need %zu)\n", n_in, ws_size, (size_t)WS_END); grid = -1; return; }
        int dev = 0, cus = 0, per_cu = 0;
        if (hipGetDevice(&dev) != hipSuccess || hipDeviceGetAttribute(&cus, hipDeviceAttributeMultiprocessorCount, dev) != hipSuccess) { grid = -1; return; }
        if (hipFuncSetAttribute((const void*)yoco_fwd, hipFuncAttributeMaxDynamicSharedMemorySize, LDS_BYTES) != hipSuccess) { fprintf(stderr, "kernel_launch: hipFuncSetAttribute failed\n"); grid = -1; return; }
        if (hipOccupancyMaxActiveBlocksPerMultiprocessor(&per_cu, (const void*)yoco_fwd, NWAVES * 64, LDS_BYTES) != hipSuccess || per_cu < 1) { fprintf(stderr, "kernel_launch: occupancy query says %d\n", per_cu); per_cu = 1; }
        (void)hipGetLastError();
        grid = cus;
        if (grid > cus * per_cu) grid = cus * per_cu;
        grid &= ~7;
    }
    if (grid <= 0) return;
    Args a{};
    const float* const* in = (const float* const*)d_in;
    a.p.x_prompt = in[0]; a.p.x_sample = in[1]; a.p.state_conv = in[2]; a.p.cache_k = in[3]; a.p.cache_v = in[4]; a.p.w_in_a = in[5]; a.p.conv_w = in[6]; a.p.w_out_a = in[7];
    a.p.w_kv = in[8]; a.p.w_q = in[9]; a.p.w_o = in[10]; a.p.rel_bias = in[11]; a.p.ln_g = in[12]; a.p.ln_b = in[13]; a.p.w_gate_up = in[14]; a.p.w_down = in[15];
    a.p.out = (float*)d_out; a.p.ws = (unsigned char*)d_ws;
#if MK_ONE_LAUNCH
    if (hipMemsetAsync((char*)d_ws + WS_CTL, 0, CTL_ZERO_BYTES, stream) != hipSuccess) { fprintf(stderr, "kernel_launch: memset failed\n"); return; }
    a.ph_lo = 0; a.ph_hi = N_PHASES;
    hipLaunchKernelGGL(yoco_fwd, dim3(grid), dim3(NWAVES * 64), LDS_BYTES, stream, a);
#else
    for (int ph = 0; ph < N_PHASES; ++ph) { a.ph_lo = ph; a.ph_hi = ph + 1; hipLaunchKernelGGL(yoco_fwd, dim3(grid), dim3(NWAVES * 64), LDS_BYTES, stream, a); }
#endif
}
```
